# Optimizing an MI355X kernel written in HIP

```python
import math
import jax
import jax.numpy as jnp
from jax import lax
import numpy as np

D_MODEL = 1024
BATCH = 32
SEQ = 2048
DEPTH = 2

GRID_W = 64
CTX_LEN = 256
N_EVEN = (DEPTH + 1) // 2
N_ODD = DEPTH // 2
N_MOD = 6
FNET_GROUPS = 4
FNET_GROUP_DIM = 128
FNET_WIDTH = FNET_GROUPS * FNET_GROUP_DIM
NA_HEADS = 8
NA_HEAD_DIM = 64
NA_WIDTH = NA_HEADS * NA_HEAD_DIM
NA_KH_MAX = 8
NA_KW = 16
EVEN_IN_WIDTH = FNET_WIDTH + 3 * NA_WIDTH
EVEN_MIX_WIDTH = FNET_WIDTH + NA_WIDTH
GQA_Q_HEADS = 12
GQA_KV_HEADS = 3
GQA_HEAD_DIM = 64
GQA_Q_WIDTH = GQA_Q_HEADS * GQA_HEAD_DIM
GQA_KV_WIDTH = GQA_KV_HEADS * GQA_HEAD_DIM
Q_BLOCK = 128
ROPE_THETA = 10000.0
S5_GROUPS = 16
S5_GROUP_DIM = 16
S5_WIDTH = S5_GROUPS * S5_GROUP_DIM
S5_STATE = 64
S5_DT_MIN = 0.001
S5_DT_MAX = 0.1
ODD_IN_WIDTH = GQA_Q_WIDTH + 2 * GQA_KV_WIDTH + S5_WIDTH
ODD_MIX_WIDTH = GQA_Q_WIDTH + S5_WIDTH
D_FF_DENSE = 2816
N_EXPERTS = 8
TOP_K = 2
D_FF_EXPERT = 3584

EPS = 1e-6
NEG_INF = -1e30

kernel_name = 'hybrid_fourier_natten_gqa_s5_moe_dit'


def rms_norm(x, gain):
    xf = x.astype(jnp.float32)
    y = xf * lax.rsqrt(jnp.mean(xf * xf, axis=-1, keepdims=True) + EPS)
    return (y * gain.astype(jnp.float32)).astype(x.dtype)


def ada_modulation(cond, w_mod, b_mod):
    m = jax.nn.silu(cond) @ w_mod + b_mod
    return jnp.split(m, N_MOD, axis=-1)


def modulate(h, shift, scale):
    return h * (1.0 + scale) + shift


def swiglu(h, w1, w3, w2):
    return (jax.nn.silu(h @ w1) * (h @ w3)) @ w2


def split_heads(t, n_heads, head_dim):
    return t.reshape(t.shape[0], t.shape[1], n_heads, head_dim)


def axial_rope(n_tokens, head_dim):
    t = jnp.arange(n_tokens)
    row = (t // GRID_W).astype(jnp.float32)
    col = (t % GRID_W).astype(jnp.float32)
    n_pairs_axis = head_dim // 4
    freqs = ROPE_THETA ** (-jnp.arange(n_pairs_axis, dtype=jnp.float32) / n_pairs_axis)
    ang = jnp.concatenate([row[:, None] * freqs, col[:, None] * freqs], axis=-1)
    return jnp.cos(ang)[None, :, None, :], jnp.sin(ang)[None, :, None, :]


def apply_rope(x, cos, sin):
    xf = x.astype(jnp.float32)
    x1, x2 = xf[..., 0::2], xf[..., 1::2]
    out = jnp.stack([x1 * cos - x2 * sin, x1 * sin + x2 * cos], axis=-1)
    return out.reshape(x.shape).astype(x.dtype)


def fourier_mix(u):
    b, n, _ = u.shape
    ug = u.astype(jnp.float32).reshape(b, n, FNET_GROUPS, FNET_GROUP_DIM)
    y = jnp.fft.fft2(ug, axes=(1, 3), norm='ortho').real
    return y.reshape(b, n, FNET_WIDTH).astype(u.dtype)


def context_attention(q, k, v):
    b, lq, hq, dh = q.shape
    hkv = k.shape[2]
    qg = q.reshape(b, lq, hkv, hq // hkv, dh)
    s = jnp.einsum('bqhgd,bkhd->bhgqk', qg, k).astype(jnp.float32) * dh ** -0.5
    p = jax.nn.softmax(s, axis=-1).astype(v.dtype)
    o = jnp.einsum('bhgqk,bkhd->bqhgd', p, v)
    return o.reshape(b, lq, hq * dh)


def block_sweep_attention(q, k_all, v_all):
    b, n, hq, dh = q.shape
    hkv = k_all.shape[2]
    g = hq // hkv
    nb = n // Q_BLOCK
    qb = q.reshape(b, nb, Q_BLOCK, hkv, g, dh).transpose(1, 0, 2, 3, 4, 5)

    def one_block(q_blk):
        s = jnp.einsum('bqhgd,bkhd->bhgqk', q_blk, k_all).astype(jnp.float32) * dh ** -0.5
        p = jax.nn.softmax(s, axis=-1).astype(v_all.dtype)
        return jnp.einsum('bhgqk,bkhd->bqhgd', p, v_all)

    o = lax.map(one_block, qb)
    return o.transpose(1, 0, 2, 3, 4, 5).reshape(b, n, hq * dh)


def neighbourhood_attention(q, k, v, k_ctx, v_ctx, rpb):
    b, n, h, dh = q.shape
    rows = n // GRID_W
    kh = min(NA_KH_MAX, rows)
    qg = q.reshape(b, rows, GRID_W, h, dh)
    kg = k.reshape(b, rows, GRID_W, h, dh)
    vg = v.reshape(b, rows, GRID_W, h, dh)
    qcol = jnp.arange(GRID_W)
    kcol = jnp.arange(GRID_W)
    col_start = jnp.clip(qcol - NA_KW // 2, 0, GRID_W - NA_KW)
    col_in = (kcol[None, :] >= col_start[:, None]) & (kcol[None, :] < col_start[:, None] + NA_KW)
    mask = jnp.broadcast_to(col_in[:, None, :], (GRID_W, kh, GRID_W)).reshape(GRID_W, kh * GRID_W)
    dc_idx = jnp.clip(kcol[None, :] - qcol[:, None] + NA_KW - 1, 0, 2 * NA_KW - 2)
    scale = dh ** -0.5

    def one_row(r):
        r0 = jnp.clip(r - kh // 2, 0, rows - kh)
        kb = lax.dynamic_slice_in_dim(kg, r0, kh, axis=1).reshape(b, kh * GRID_W, h, dh)
        vb = lax.dynamic_slice_in_dim(vg, r0, kh, axis=1).reshape(b, kh * GRID_W, h, dh)
        qr = lax.dynamic_index_in_dim(qg, r, axis=1, keepdims=False)
        dr_idx = r0 + jnp.arange(kh) - r + NA_KH_MAX - 1
        bias = rpb[:, dr_idx][:, :, dc_idx]
        bias = bias.transpose(0, 2, 1, 3).reshape(h, GRID_W, kh * GRID_W).astype(jnp.float32)
        s_loc = jnp.einsum('bqhd,bkhd->bhqk', qr, kb).astype(jnp.float32) * scale + bias
        s_loc = jnp.where(mask, s_loc, NEG_INF)
        s_ctx = jnp.einsum('bqhd,bkhd->bhqk', qr, k_ctx).astype(jnp.float32) * scale
        p = jax.nn.softmax(jnp.concatenate([s_loc, s_ctx], axis=-1), axis=-1).astype(v.dtype)
        n_loc = kh * GRID_W
        return (jnp.einsum('bhqk,bkhd->bqhd', p[..., :n_loc], vb)
                + jnp.einsum('bhqk,bkhd->bqhd', p[..., n_loc:], v_ctx))

    o = lax.map(one_row, jnp.arange(rows))
    return o.transpose(1, 0, 2, 3, 4).reshape(b, n, h * dh)


def _linear_combine(left, right):
    a_l, b_l = left
    a_r, b_r = right
    return a_r * a_l, a_r * b_l + b_r


def linear_recurrence(lam_bar, bu, s0):
    if s0 is not None:
        bu = bu.at[:, 0].add(lam_bar * s0)
    a = jnp.broadcast_to(lam_bar, bu.shape)
    _, states = lax.associative_scan(_linear_combine, (a, bu), axis=1)
    return states


def s5_direction(ug_lat, ug_ctx, a_re, a_im, log_step, b_re, b_im, c_re, c_im, reverse, with_ctx_out):
    lam = lax.complex(a_re.astype(jnp.float32), a_im.astype(jnp.float32))
    step = jnp.exp(log_step.astype(jnp.float32))[:, None]
    lam_bar = jnp.exp(lam * step)
    b_mat = lax.complex(b_re.astype(jnp.float32), b_im.astype(jnp.float32))
    b_bar = ((lam_bar - 1.0) / lam)[..., None] * b_mat
    c_mat = lax.complex(c_re.astype(jnp.float32), c_im.astype(jnp.float32))

    def orient(z):
        return jnp.flip(z, axis=1) if reverse else z

    bu_ctx = jnp.einsum('blgn,gpn->blgp', orient(ug_ctx).astype(jnp.complex64), b_bar)
    st_ctx = linear_recurrence(lam_bar, bu_ctx, None)
    bu_lat = jnp.einsum('blgn,gpn->blgp', orient(ug_lat).astype(jnp.complex64), b_bar)
    st_lat = linear_recurrence(lam_bar, bu_lat, st_ctx[:, -1])
    y_lat = orient(jnp.einsum('blgp,gnp->blgn', st_lat, c_mat).real)
    y_ctx = orient(jnp.einsum('blgp,gnp->blgn', st_ctx, c_mat).real) if with_ctx_out else None
    return y_lat, y_ctx


def s5_mixer(u_lat, u_ctx, a_re, a_im, log_step, b_re, b_im, c_re, c_im, d_skip, glu_w, glu_b, with_ctx_out):
    def groups(u):
        return u.astype(jnp.float32).reshape(u.shape[0], u.shape[1], S5_GROUPS, S5_GROUP_DIM)

    ug_lat, ug_ctx = groups(u_lat), groups(u_ctx)
    y_lat, y_ctx = None, None
    for direction, reverse in ((0, False), (1, True)):
        yl, yc = s5_direction(ug_lat, ug_ctx, a_re[direction], a_im[direction], log_step[direction],
                              b_re[direction], b_im[direction], c_re[direction], c_im[direction],
                              reverse, with_ctx_out)
        y_lat = yl if y_lat is None else y_lat + yl
        if with_ctx_out:
            y_ctx = yc if y_ctx is None else y_ctx + yc

    def readout(u, y):
        y = y.reshape(u.shape) + d_skip.astype(jnp.float32) * u.astype(jnp.float32)
        y = jax.nn.gelu(y).astype(u.dtype)
        return y * jax.nn.sigmoid(y @ glu_w + glu_b)

    out_ctx = readout(u_ctx, y_ctx) if with_ctx_out else None
    return readout(u_lat, y_lat), out_ctx


def moe_swiglu(h, router_w, router_b, w1, w3, w2):
    shape = h.shape
    t = h.reshape(-1, shape[-1])
    logits = (t @ router_w + router_b).astype(jnp.float32)
    top_val, top_idx = lax.top_k(logits, TOP_K)
    top_w = jax.nn.softmax(top_val, axis=-1)
    gates = jnp.einsum('tk,tke->te', top_w,
                       jax.nn.one_hot(top_idx, N_EXPERTS, dtype=jnp.float32)).astype(t.dtype)
    out = jnp.zeros_like(t)
    for e in range(N_EXPERTS):
        out = out + gates[:, e:e + 1] * swiglu(t, w1[e], w3[e], w2[e])
    return out.reshape(shape)


def even_layer(x, xc, c, c_ctx, mod_w, mod_b, norm_mix, norm_ffn, w_in, q_gain, k_gain, rpb, w_out,
               w1, w3, w2, update_ctx):
    sh1, sc1, g1, sh2, sc2, g2 = ada_modulation(c[:, None, :], mod_w, mod_b)
    csh1, csc1, cg1, csh2, csc2, cg2 = ada_modulation(c_ctx, mod_w, mod_b)
    cuts = [FNET_WIDTH, FNET_WIDTH + NA_WIDTH, FNET_WIDTH + 2 * NA_WIDTH]
    h = modulate(rms_norm(x, norm_mix), sh1, sc1) @ w_in
    hc = modulate(rms_norm(xc, norm_mix), csh1, csc1) @ w_in
    u, q, k, v = jnp.split(h, cuts, axis=-1)
    uc, qc, kc, vc = jnp.split(hc, cuts, axis=-1)
    q = rms_norm(split_heads(q, NA_HEADS, NA_HEAD_DIM), q_gain)
    k = rms_norm(split_heads(k, NA_HEADS, NA_HEAD_DIM), k_gain)
    v = split_heads(v, NA_HEADS, NA_HEAD_DIM)
    kc = rms_norm(split_heads(kc, NA_HEADS, NA_HEAD_DIM), k_gain)
    vc = split_heads(vc, NA_HEADS, NA_HEAD_DIM)
    o_lat = jnp.concatenate([fourier_mix(u), neighbourhood_attention(q, k, v, kc, vc, rpb)], axis=-1)
    x = x + g1 * (o_lat @ w_out)
    if update_ctx:
        qc = rms_norm(split_heads(qc, NA_HEADS, NA_HEAD_DIM), q_gain)
        o_ctx = jnp.concatenate([fourier_mix(uc), context_attention(qc, kc, vc)], axis=-1)
        xc = xc + cg1 * (o_ctx @ w_out)
    x = x + g2 * swiglu(modulate(rms_norm(x, norm_ffn), sh2, sc2), w1, w3, w2)
    if update_ctx:
        xc = xc + cg2 * swiglu(modulate(rms_norm(xc, norm_ffn), csh2, csc2), w1, w3, w2)
    return x, xc


def odd_layer(x, xc, c, c_ctx, mod_w, mod_b, norm_mix, norm_ffn, w_in, q_gain, k_gain,
              a_re, a_im, log_step, b_re, b_im, c_re, c_im, d_skip, glu_w, glu_b, w_out,
              router_w, router_b, ew1, ew3, ew2, update_ctx):
    sh1, sc1, g1, sh2, sc2, g2 = ada_modulation(c[:, None, :], mod_w, mod_b)
    csh1, csc1, cg1, csh2, csc2, cg2 = ada_modulation(c_ctx, mod_w, mod_b)
    cuts = [GQA_Q_WIDTH, GQA_Q_WIDTH + GQA_KV_WIDTH, GQA_Q_WIDTH + 2 * GQA_KV_WIDTH]
    h = modulate(rms_norm(x, norm_mix), sh1, sc1) @ w_in
    hc = modulate(rms_norm(xc, norm_mix), csh1, csc1) @ w_in
    q, k, v, u = jnp.split(h, cuts, axis=-1)
    qc, kc, vc, uc = jnp.split(hc, cuts, axis=-1)
    cos, sin = axial_rope(x.shape[1], GQA_HEAD_DIM)
    q = apply_rope(rms_norm(split_heads(q, GQA_Q_HEADS, GQA_HEAD_DIM), q_gain), cos, sin)
    k = apply_rope(rms_norm(split_heads(k, GQA_KV_HEADS, GQA_HEAD_DIM), k_gain), cos, sin)
    v = split_heads(v, GQA_KV_HEADS, GQA_HEAD_DIM)
    kc = rms_norm(split_heads(kc, GQA_KV_HEADS, GQA_HEAD_DIM), k_gain)
    vc = split_heads(vc, GQA_KV_HEADS, GQA_HEAD_DIM)
    k_all = jnp.concatenate([kc, k], axis=1)
    v_all = jnp.concatenate([vc, v], axis=1)
    o_attn = block_sweep_attention(q, k_all, v_all)
    o_ssm, oc_ssm = s5_mixer(u, uc, a_re, a_im, log_step, b_re, b_im, c_re, c_im, d_skip, glu_w, glu_b,
                             update_ctx)
    x = x + g1 * (jnp.concatenate([o_attn, o_ssm], axis=-1) @ w_out)
    if update_ctx:
        qc = rms_norm(split_heads(qc, GQA_Q_HEADS, GQA_HEAD_DIM), q_gain)
        o_ctx = jnp.concatenate([context_attention(qc, kc, vc), oc_ssm], axis=-1)
        xc = xc + cg1 * (o_ctx @ w_out)
    x = x + g2 * moe_swiglu(modulate(rms_norm(x, norm_ffn), sh2, sc2), router_w, router_b, ew1, ew3, ew2)
    if update_ctx:
        xc = xc + cg2 * moe_swiglu(modulate(rms_norm(xc, norm_ffn), csh2, csc2),
                                   router_w, router_b, ew1, ew3, ew2)
    return x, xc


def setup_inputs(seed: int = 0) -> dict:
    key = jax.random.key(seed)
    keys = iter(jax.random.split(key, 64))

    def normal(shape, scale):
        return scale * jax.random.normal(next(keys), shape, jnp.float32)

    def gain(shape):
        return 1.0 + normal(shape, 0.05)

    d = D_MODEL
    ne, no = N_EVEN, N_ODD
    s5_shape = (no, 2, S5_GROUPS, S5_STATE)
    n_idx = jnp.arange(S5_STATE, dtype=jnp.float32)
    log_lo, log_hi = math.log(S5_DT_MIN), math.log(S5_DT_MAX)
    inp = {}
    inp['x'] = normal((BATCH, SEQ, d), 1.0)
    inp['c'] = normal((BATCH, d), 1.0)
    inp['ctx'] = normal((BATCH, CTX_LEN, d), 1.0)
    inp['c_ctx'] = normal((d,), 0.5)
    inp['ev_mod_w'] = normal((ne, d, N_MOD * d), 0.5 * d ** -0.5)
    inp['ev_mod_b'] = normal((ne, N_MOD * d), 0.02)
    inp['ev_norm_mix'] = gain((ne, d))
    inp['ev_norm_ffn'] = gain((ne, d))
    inp['ev_w_in'] = normal((ne, d, EVEN_IN_WIDTH), d ** -0.5)
    inp['ev_q_gain'] = gain((ne, NA_HEAD_DIM))
    inp['ev_k_gain'] = gain((ne, NA_HEAD_DIM))
    inp['ev_rpb'] = normal((ne, NA_HEADS, 2 * NA_KH_MAX - 1, 2 * NA_KW - 1), 0.1)
    inp['ev_w_out'] = normal((ne, EVEN_MIX_WIDTH, d), EVEN_MIX_WIDTH ** -0.5)
    inp['ev_ffn_w1'] = normal((ne, d, D_FF_DENSE), d ** -0.5)
    inp['ev_ffn_w3'] = normal((ne, d, D_FF_DENSE), d ** -0.5)
    inp['ev_ffn_w2'] = normal((ne, D_FF_DENSE, d), D_FF_DENSE ** -0.5)
    inp['od_mod_w'] = normal((no, d, N_MOD * d), 0.5 * d ** -0.5)
    inp['od_mod_b'] = normal((no, N_MOD * d), 0.02)
    inp['od_norm_mix'] = gain((no, d))
    inp['od_norm_ffn'] = gain((no, d))
    inp['od_w_in'] = normal((no, d, ODD_IN_WIDTH), d ** -0.5)
    inp['od_q_gain'] = gain((no, GQA_HEAD_DIM))
    inp['od_k_gain'] = gain((no, GQA_HEAD_DIM))
    inp['od_s5_a_re'] = -0.5 + normal(s5_shape, 0.01)
    inp['od_s5_a_im'] = jnp.pi * n_idx + normal(s5_shape, 0.01)
    inp['od_s5_log_step'] = log_lo + (log_hi - log_lo) * jax.random.uniform(
        next(keys), (no, 2, S5_GROUPS), jnp.float32)
    inp['od_s5_b_re'] = normal((no, 2, S5_GROUPS, S5_STATE, S5_GROUP_DIM), S5_GROUP_DIM ** -0.5)
    inp['od_s5_b_im'] = normal((no, 2, S5_GROUPS, S5_STATE, S5_GROUP_DIM), S5_GROUP_DIM ** -0.5)
    inp['od_s5_c_re'] = normal((no, 2, S5_GROUPS, S5_GROUP_DIM, S5_STATE), S5_STATE ** -0.5)
    inp['od_s5_c_im'] = normal((no, 2, S5_GROUPS, S5_GROUP_DIM, S5_STATE), S5_STATE ** -0.5)
    inp['od_s5_d'] = normal((no, S5_WIDTH), 1.0)
    inp['od_s5_glu_w'] = normal((no, S5_WIDTH, S5_WIDTH), S5_WIDTH ** -0.5)
    inp['od_s5_glu_b'] = normal((no, S5_WIDTH), 0.02)
    inp['od_w_out'] = normal((no, ODD_MIX_WIDTH, d), ODD_MIX_WIDTH ** -0.5)
    inp['od_router_w'] = normal((no, d, N_EXPERTS), d ** -0.5)
    inp['od_router_b'] = normal((no, N_EXPERTS), 0.01)
    inp['od_exp_w1'] = normal((no, N_EXPERTS, d, D_FF_EXPERT), d ** -0.5)
    inp['od_exp_w3'] = normal((no, N_EXPERTS, d, D_FF_EXPERT), d ** -0.5)
    inp['od_exp_w2'] = normal((no, N_EXPERTS, D_FF_EXPERT, d), D_FF_EXPERT ** -0.5)
    return inp


def reference(x, c, ctx, c_ctx,
              ev_mod_w, ev_mod_b, ev_norm_mix, ev_norm_ffn, ev_w_in, ev_q_gain, ev_k_gain, ev_rpb, ev_w_out,
              ev_ffn_w1, ev_ffn_w3, ev_ffn_w2,
              od_mod_w, od_mod_b, od_norm_mix, od_norm_ffn, od_w_in, od_q_gain, od_k_gain,
              od_s5_a_re, od_s5_a_im, od_s5_log_step, od_s5_b_re, od_s5_b_im, od_s5_c_re, od_s5_c_im,
              od_s5_d, od_s5_glu_w, od_s5_glu_b, od_w_out,
              od_router_w, od_router_b, od_exp_w1, od_exp_w3, od_exp_w2):
    xc = ctx
    for layer in range(DEPTH):
        update_ctx = layer < DEPTH - 1
        j = layer // 2
        if layer % 2 == 0:
            x, xc = even_layer(x, xc, c, c_ctx, ev_mod_w[j], ev_mod_b[j], ev_norm_mix[j], ev_norm_ffn[j],
                               ev_w_in[j], ev_q_gain[j], ev_k_gain[j], ev_rpb[j], ev_w_out[j],
                               ev_ffn_w1[j], ev_ffn_w3[j], ev_ffn_w2[j], update_ctx)
        else:
            x, xc = odd_layer(x, xc, c, c_ctx, od_mod_w[j], od_mod_b[j], od_norm_mix[j], od_norm_ffn[j],
                              od_w_in[j], od_q_gain[j], od_k_gain[j],
                              od_s5_a_re[j], od_s5_a_im[j], od_s5_log_step[j], od_s5_b_re[j], od_s5_b_im[j],
                              od_s5_c_re[j], od_s5_c_im[j], od_s5_d[j], od_s5_glu_w[j], od_s5_glu_b[j],
                              od_w_out[j], od_router_w[j], od_router_b[j],
                              od_exp_w1[j], od_exp_w3[j], od_exp_w2[j], update_ctx)
    return x
```

```cpp
#include <hip/hip_runtime.h>
#include <hip/hip_bf16.h>
#include <cstdio>
#include <cstdint>
#include <cmath>

#ifndef MK_PER_PHASE
#define MK_PER_PHASE 0
#endif

namespace pg8 {
#define PG8_LAS __attribute__((address_space(3)))
typedef unsigned short bf16_t;
typedef short bf16x8 __attribute__((ext_vector_type(8)));
typedef float f32x4 __attribute__((ext_vector_type(4)));
typedef unsigned u32x4 __attribute__((ext_vector_type(4)));
typedef unsigned u32x2 __attribute__((ext_vector_type(2)));
typedef int i32x4 __attribute__((ext_vector_type(4)));
typedef int i32x8 __attribute__((ext_vector_type(8)));
constexpr int BM = 256, BK = 64, HALF = 128, HTB = HALF * BK * 2, STAGE_BYTES = 8 * HTB, NXCD = 8, WGM = 8;

__host__ __device__ __forceinline__ int lds_byte(int r, int c) { const int st = (r >> 4) * 2 + (c >> 5), rr = r & 15, cc = c & 31, ob = rr * 64 + cc * 2; return st * 1024 + (ob ^ (((ob >> 9) & 1) << 5)); }
__host__ __device__ __forceinline__ void stage_rc(int b, int& R, int& C) { const int st = b / 1024, sb = b % 1024, swz = sb ^ (((sb >> 9) & 1) << 5); R = (st >> 1) * 16 + swz / 64; C = (st & 1) * 32 + (swz % 64) / 2; }
__host__ __device__ __forceinline__ int perm32(int rho) { const int n = rho >> 4, i = rho & 15; return 8 * (i >> 2) + 4 * n + (i & 3); }

struct Unit { int pm, pn, z, aux; size_t aoff, boff; };
struct Gemm { const bf16_t* A; const bf16_t* Bt; int lda, ldb, K; };

enum { OM_PLAIN = 0, OM_LAT = 1, OM_ZB = 2, OM_ZAB = 3, OM_MOE = 4 };
struct Order {
    int nM, nN, nwg, G, c, mode, nMz, pbase, apan0; size_t tA, tB, zA, zB; const unsigned* pexp;
    __device__ __forceinline__ void init(int nM_, int nN_, int G_, int c_, int mode_, int nMz_, size_t tA_, size_t tB_, size_t zA_, size_t zB_) {
        nM = nM_; nN = nN_; nwg = nM_ * nN_; G = G_; c = c_; mode = mode_; nMz = nMz_; tA = tA_; tB = tB_; zA = zA_; zB = zB_; pexp = nullptr; pbase = 0; apan0 = 0; }
    __device__ __forceinline__ bool next(int i, Unit& u) const {
        const long L = (long)i * G + c; if (L >= nwg) return false;
        int wgid = (int)L; { const int q = nwg / NXCD, r = nwg % NXCD, xcd = wgid % NXCD, off = wgid / NXCD; wgid = (xcd < r ? xcd * (q + 1) : r * (q + 1) + (xcd - r) * q) + off; }
        const int nig = WGM * nN, gid = wgid / nig, fm = gid * WGM, gsz = (nM - fm) < WGM ? (nM - fm) : WGM;
        const int pmz = fm + ((wgid % nig) % gsz), pn = (wgid % nig) / gsz;
        u.pn = pn; u.aux = pmz;
        if (mode == OM_PLAIN) { u.z = 0; u.pm = pmz; u.aoff = (size_t)pmz * tA; u.boff = (size_t)pn * tB; }
        else if (mode == OM_LAT) { u.z = 0; u.pm = (pmz >> 3) * 9 + 1 + (pmz & 7); u.aoff = (size_t)u.pm * tA; u.boff = (size_t)pn * tB; }
        else if (mode == OM_ZB) { u.z = pmz / nMz; u.pm = pmz % nMz; u.aoff = (size_t)u.pm * tA; u.boff = (size_t)u.z * zB + (size_t)pn * tB; }
        else if (mode == OM_ZAB) { u.z = pmz / nMz; u.pm = pmz % nMz; u.aoff = (size_t)u.z * zA + (size_t)u.pm * tA; u.boff = (size_t)u.z * zB + (size_t)pn * tB; }
        else { u.pm = pbase + pmz; u.z = (int)__builtin_amdgcn_readfirstlane(__hip_atomic_load(pexp + u.pm, __ATOMIC_RELAXED, __HIP_MEMORY_SCOPE_AGENT));
               u.aoff = (size_t)(apan0 + pmz) * tA; u.boff = (size_t)u.z * zB + (size_t)pn * tB; }
        return true;
    }
    __device__ __forceinline__ void a_ready(const Unit&) const {}
    __device__ __forceinline__ void done(const Unit&) const {}
};

__device__ __forceinline__ unsigned cvt_pk_bf16(float lo, float hi) { unsigned r; asm volatile("v_cvt_pk_bf16_f32 %0, %1, %2" : "=v"(r) : "v"(lo), "v"(hi)); return r; }

template <class Epi, class Sched, bool ALIGN_EPI, bool FP8 = false>
__device__ __forceinline__ void gemm_phase(PG8_LAS unsigned char* lds, const Gemm g, const Sched& S, const Epi& E) {
    const int tid = threadIdx.x, wid = __builtin_amdgcn_readfirstlane(tid >> 6), lane = tid & 63, wr = wid >> 2, wc = wid & 3, fr = lane & 15, fq = lane >> 4;
    constexpr int ESZ = FP8 ? 1 : 2;
    const int nt = FP8 ? g.K / (2 * BK) : g.K / BK;
    unsigned voffA[2], voffB[2];
#pragma unroll
    for (int i = 0; i < 2; ++i) { int R, C; stage_rc(tid * 16 + i * 8192, R, C); const int Rb = Epi::PERM ? ((R & ~31) + perm32(R & 31)) : R;
        voffA[i] = (unsigned)(R * g.lda * ESZ + C * 2); voffB[i] = (unsigned)(Rb * g.ldb * ESZ + C * 2); }
    const size_t kstep = (size_t)(BK * 2);
    const size_t hstepA = (size_t)HALF * g.lda * ESZ, hstepB = (size_t)HALF * g.ldb * ESZ;
    const unsigned ldsw = (unsigned)wid * 1024u;
    const int aoff = lds_byte(wr * 64 + fr, fq * 8), boff = lds_byte(wc * 32 + fr, fq * 8);
#define PG8_SA(b, h) (((b) * 2 + (h)) * HTB)
#define PG8_SB(b, h) ((4 + (b) * 2 + (h)) * HTB)
#define PG8_STAGE(bufoff, gbase, voff) do { _Pragma("unroll") for (int _i = 0; _i < 2; ++_i) \
        __builtin_amdgcn_global_load_lds((const unsigned*)((const char*)(gbase) + (voff)[_i]), (PG8_LAS unsigned*)(lds + (bufoff) + ldsw + _i * 8192), 16, 0, 0); } while (0)
#define PG8_LDA(dst, b, h) do { _Pragma("unroll") for (int m = 0; m < 4; ++m) { if constexpr (FP8) { const i32x4 lo_ = *(const PG8_LAS i32x4*)(lds + PG8_SA(b, h) + aoff + m * 2048), hi_ = *(const PG8_LAS i32x4*)(lds + PG8_SA(b, h) + aoff + m * 2048 + 1024); \
        dst##8[m] = __builtin_shufflevector(lo_, hi_, 0, 1, 2, 3, 4, 5, 6, 7); } else { _Pragma("unroll") for (int k = 0; k < 2; ++k) dst[m][k] = *(const PG8_LAS bf16x8*)(lds + PG8_SA(b, h) + aoff + m * 2048 + k * 1024); } } } while (0)
#define PG8_LDB(dst, b, h) do { _Pragma("unroll") for (int n = 0; n < 2; ++n) { if constexpr (FP8) { const i32x4 lo_ = *(const PG8_LAS i32x4*)(lds + PG8_SB(b, h) + boff + n * 2048), hi_ = *(const PG8_LAS i32x4*)(lds + PG8_SB(b, h) + boff + n * 2048 + 1024); \
        dst##8[n] = __builtin_shufflevector(lo_, hi_, 0, 1, 2, 3, 4, 5, 6, 7); } else { _Pragma("unroll") for (int k = 0; k < 2; ++k) dst[n][k] = *(const PG8_LAS bf16x8*)(lds + PG8_SB(b, h) + boff + n * 2048 + k * 1024); } } } while (0)
#define PG8_MMA(ai, bj, At, Bt) do { __builtin_amdgcn_s_setprio(1); _Pragma("unroll") for (int m = 0; m < 4; ++m) _Pragma("unroll") for (int n = 0; n < 2; ++n) { \
        if constexpr (FP8) { asm volatile("v_mfma_f32_16x16x128_f8f6f4 %0, %1, %2, %0" : "+v"(acc[ai][bj][m][n]) : "v"(Bt##8[n]), "v"(At##8[m])); } \
        else { _Pragma("unroll") for (int k = 0; k < 2; ++k) acc[ai][bj][m][n] = __builtin_amdgcn_mfma_f32_16x16x32_bf16(Bt[n][k], At[m][k], acc[ai][bj][m][n], 0, 0, 0); } } \
        __builtin_amdgcn_s_setprio(0); } while (0)
#define PG8_WAIT_V(n) asm volatile("s_waitcnt vmcnt(" #n ")" ::: "memory")
#define PG8_WAIT_L(n) asm volatile("s_waitcnt lgkmcnt(" #n ")" ::: "memory")
#define PG8_BAR __builtin_amdgcn_s_barrier()
#define PG8_SCHED __builtin_amdgcn_sched_barrier(0)
    Unit cur, nxt; int ui = 0;
    if (!S.next(0, cur)) return;
    f32x4 acc[2][2][4][2];
#pragma unroll
    for (int a = 0; a < 2; ++a)
#pragma unroll
        for (int b = 0; b < 2; ++b)
#pragma unroll
            for (int m = 0; m < 4; ++m)
#pragma unroll
                for (int n = 0; n < 2; ++n) acc[a][b][m][n] = (f32x4){0.f, 0.f, 0.f, 0.f};
    bf16x8 At[4][2], B0[2][2], B1[2][2]; i32x8 At8[4], B08[2], B18[2];
    const char* cA = (const char*)g.A + cur.aoff; const char* cB = (const char*)g.Bt + cur.boff;
    S.a_ready(cur);
    PG8_STAGE(PG8_SB(0, 0), cB, voffB); PG8_STAGE(PG8_SB(0, 1), cB + hstepB, voffB); PG8_STAGE(PG8_SA(0, 0), cA, voffA); PG8_STAGE(PG8_SA(0, 1), cA + hstepA, voffA);
    if (wr == 1) PG8_BAR;
    PG8_WAIT_V(2); PG8_BAR;
    PG8_STAGE(PG8_SB(1, 0), cB + kstep, voffB); PG8_STAGE(PG8_SA(1, 0), cA + kstep, voffA); PG8_STAGE(PG8_SB(1, 1), cB + hstepB + kstep, voffB);
    PG8_WAIT_V(6); PG8_BAR;
    for (;;) {
        const bool has_next = S.next(ui + 1, nxt);
        const char* nA = has_next ? (const char*)g.A + nxt.aoff : cA; const char* nB = has_next ? (const char*)g.Bt + nxt.boff : cB;
#pragma unroll 1
        for (int t = 0; t < nt; t += 2) {
            const bool last = (t == nt - 2);
            const char* a1 = cA + (size_t)(t + 1) * kstep;
            const char* a2 = last ? nA : cA + (size_t)(t + 2) * kstep; const char* b2 = last ? nB : cB + (size_t)(t + 2) * kstep;
            const char* a3 = a2 + kstep; const char* b3 = b2 + kstep;
            if (last && has_next) S.a_ready(nxt);
            PG8_LDB(B0, 0, 0); PG8_LDB(B1, 0, 1); PG8_SCHED; PG8_LDA(At, 0, 0); PG8_STAGE(PG8_SA(1, 1), a1 + hstepA, voffA);
            PG8_WAIT_V(8); PG8_WAIT_L(0); PG8_BAR; PG8_MMA(0, 0, At, B0); PG8_MMA(0, 1, At, B1); PG8_BAR; PG8_SCHED;
            PG8_LDA(At, 0, 1); PG8_STAGE(PG8_SB(0, 0), b2, voffB); PG8_STAGE(PG8_SB(0, 1), b2 + hstepB, voffB); PG8_STAGE(PG8_SA(0, 0), a2, voffA);
            PG8_WAIT_V(8); PG8_WAIT_L(0); PG8_BAR; PG8_MMA(1, 0, At, B0); PG8_MMA(1, 1, At, B1); PG8_BAR; PG8_SCHED;
            PG8_LDB(B0, 1, 0); PG8_LDB(B1, 1, 1); PG8_SCHED; PG8_LDA(At, 1, 0); PG8_STAGE(PG8_SA(0, 1), a2 + hstepA, voffA);
            PG8_WAIT_V(8); PG8_WAIT_L(0); PG8_BAR; PG8_MMA(0, 0, At, B0); PG8_MMA(0, 1, At, B1); PG8_BAR; PG8_SCHED;
            PG8_LDA(At, 1, 1); PG8_STAGE(PG8_SB(1, 0), b3, voffB); PG8_STAGE(PG8_SB(1, 1), b3 + hstepB, voffB); PG8_STAGE(PG8_SA(1, 0), a3, voffA);
            PG8_WAIT_V(8); PG8_WAIT_L(0); PG8_BAR; PG8_MMA(1, 0, At, B0); PG8_MMA(1, 1, At, B1); PG8_BAR; PG8_SCHED;
        }
        if constexpr (ALIGN_EPI) { if (wr == 0) PG8_BAR; }
        if constexpr (FP8) asm volatile("s_nop 15\n\ts_nop 7" ::: "memory");
        E(acc, cur, wr, wc, fr, fq); S.done(cur);
        if (!has_next) break;
#pragma unroll
        for (int a = 0; a < 2; ++a)
#pragma unroll
            for (int b = 0; b < 2; ++b)
#pragma unroll
                for (int m = 0; m < 4; ++m)
#pragma unroll
                    for (int n = 0; n < 2; ++n) acc[a][b][m][n] = (f32x4){0.f, 0.f, 0.f, 0.f};
        cur = nxt; cA = nA; cB = nB; ++ui;
        if constexpr (ALIGN_EPI) { if (wr == 1) PG8_BAR; }
    }
    PG8_WAIT_V(0);
    if constexpr (!ALIGN_EPI) { if (wr == 0) PG8_BAR; }
    PG8_BAR;
#undef PG8_SA
#undef PG8_SB
#undef PG8_STAGE
#undef PG8_LDA
#undef PG8_LDB
#undef PG8_MMA
#undef PG8_WAIT_V
#undef PG8_WAIT_L
#undef PG8_BAR
#undef PG8_SCHED
}
}

namespace attn_body {
using bf16=__hip_bfloat16;
using bf16x8=__attribute__((ext_vector_type(8)))short;
using s16x4=__attribute__((ext_vector_type(4)))short;
using f32x16=__attribute__((ext_vector_type(16)))float;
using u32x4=__attribute__((ext_vector_type(4)))unsigned;
constexpr int D=64;
constexpr int NW=8,QBLK=32,QB=QBLK*NW,KVBLK=64;
__device__ __forceinline__ int crow(int r,int hi){return (r&3)+8*(r>>2)+4*hi;}
#define SBAR() __builtin_amdgcn_sched_barrier(0)
constexpr int NSLOT=3, SLOTB=8192;
constexpr int LDS_K=0, LDS_V=NSLOT*SLOTB, LDS_WS=2*NSLOT*SLOTB, LDS_OST=LDS_WS+NW*64*4, LDS_BYTES=LDS_OST+NW*4096;
constexpr int LDS_BT=86016;
constexpr int NA_KINDS=17, NA_KIND_CTX=15, NA_KIND_NONE=16;
__device__ __forceinline__ void glds16(const void*gsrc,unsigned lds_dst){unsigned keep;
  asm volatile("s_mov_b32 %0, m0\n\ts_mov_b32 m0, %2\n\ts_nop 0\n\tglobal_load_lds_dwordx4 %1, off\n\ts_mov_b32 m0, %0":"=&s"(keep):"v"(gsrc),"s"(lds_dst):"memory");}
__device__ __forceinline__ float max3f(float a,float b,float c){float r;asm("v_max3_f32 %0, %1, %2, %3":"=v"(r):"v"(a),"v"(b),"v"(c));return r;}
__device__ __forceinline__ float max2f(float a,float b){float r;asm("v_max_f32_e32 %0, %1, %2":"=v"(r):"v"(a),"v"(b));return r;}
__device__ __forceinline__ float fadd_s(float a,float b){float r;asm("v_add_f32_e32 %0, %1, %2":"=v"(r):"v"(a),"v"(b));return r;}
__device__ __forceinline__ float fsub_s(float a,float b){float r;asm("v_sub_f32_e32 %0, %1, %2":"=v"(r):"v"(a),"v"(b));return r;}
typedef float f32x2_t __attribute__((ext_vector_type(2))); typedef float f32x4_t __attribute__((ext_vector_type(4))); typedef __bf16 bf16x2_t __attribute__((ext_vector_type(2)));
__device__ __forceinline__ unsigned cvtpk_s(float lo,float hi){f32x2_t v={lo,hi};bf16x2_t b=__builtin_convertvector(v,bf16x2_t);return __builtin_bit_cast(unsigned,b);}
#define WAIT_BAR(N) asm volatile("s_waitcnt vmcnt(" #N ") lgkmcnt(0)\n\ts_barrier":::"memory")

__device__ __forceinline__ void qkt(f32x16&p0,f32x16&p1,const char*Kslot,const bf16x8*qr,const f32x16&negm,int r32,int hi){
  const char*kb=Kslot+hi*1024+r32*16;
  #pragma unroll
  for(int d0=0;d0<4;++d0){
    const bf16x8 b0=*reinterpret_cast<const bf16x8*>(kb+d0*2048);
    const bf16x8 b1=*reinterpret_cast<const bf16x8*>(kb+d0*2048+512);
    if(d0==0){p0=__builtin_amdgcn_mfma_f32_32x32x16_bf16(b0,qr[0],negm,0,0,0);p1=__builtin_amdgcn_mfma_f32_32x32x16_bf16(b1,qr[0],negm,0,0,0);}
    else{p0=__builtin_amdgcn_mfma_f32_32x32x16_bf16(b0,qr[d0],p0,0,0,0);p1=__builtin_amdgcn_mfma_f32_32x32x16_bf16(b1,qr[d0],p1,0,0,0);}}
}
typedef __attribute__((address_space(3))) const char* lds_cptr;
typedef __attribute__((address_space(3))) const float* lds_fptr;
typedef short v4i16_t __attribute__((ext_vector_type(4)));
__device__ __forceinline__ void kload8(bf16x8*kf,lds_cptr kp){
  kf[0]=*(const __attribute__((address_space(3))) bf16x8*)(kp);      kf[1]=*(const __attribute__((address_space(3))) bf16x8*)(kp+512);
  kf[2]=*(const __attribute__((address_space(3))) bf16x8*)(kp+2048); kf[3]=*(const __attribute__((address_space(3))) bf16x8*)(kp+2560);
  kf[4]=*(const __attribute__((address_space(3))) bf16x8*)(kp+4096); kf[5]=*(const __attribute__((address_space(3))) bf16x8*)(kp+4608);
  kf[6]=*(const __attribute__((address_space(3))) bf16x8*)(kp+6144); kf[7]=*(const __attribute__((address_space(3))) bf16x8*)(kp+6656);
}
__device__ __forceinline__ void kload2(bf16x8*kf,lds_cptr kp,int j){ kf[2*j]=*(const __attribute__((address_space(3))) bf16x8*)(kp+j*2048); kf[2*j+1]=*(const __attribute__((address_space(3))) bf16x8*)(kp+j*2048+512); }
__device__ __forceinline__ s16x4 vtr(lds_cptr p){ return __builtin_bit_cast(s16x4,__builtin_amdgcn_ds_read_tr16_b64_v4i16((__attribute__((address_space(3))) v4i16_t*)p)); }
__device__ __forceinline__ float rowmax(const f32x16&p0,const f32x16&p1){
  float a=max3f(p0[0],p0[1],p1[0]),b=max3f(p0[2],p0[3],p1[1]);a=max3f(a,p1[2],p1[3]);
  #pragma unroll
  for(int r=4;r<16;r+=4){a=max3f(a,p0[r],p0[r+1]);b=max3f(b,p0[r+2],p0[r+3]);a=max3f(a,p1[r],p1[r+1]);b=max3f(b,p1[r+2],p1[r+3]);}
  const float m=max2f(a,b);
  auto rr=__builtin_amdgcn_permlane32_swap(__float_as_uint(m),__float_as_uint(m),false,false);
  return max2f(__uint_as_float(rr[0]),__uint_as_float(rr[1]));
}
__device__ __forceinline__ void pv(f32x16*o,int vb,bf16x8 pa0,bf16x8 pa1,bf16x8 pa2,bf16x8 pa3){
  #pragma unroll
  for(int d0=0;d0<2;++d0){s16x4 lo[4],hi[4];
    #pragma unroll
    for(int ks=0;ks<4;++ks){
      asm volatile("ds_read_b64_tr_b16 %0,%1 offset:%c2":"=&v"(lo[ks]):"v"(vb),"i"(d0*4096+ks*1024):"memory");
      asm volatile("ds_read_b64_tr_b16 %0,%1 offset:%c2":"=&v"(hi[ks]):"v"(vb),"i"(d0*4096+ks*1024+512):"memory");}
    asm volatile("s_waitcnt lgkmcnt(0)":::"memory");SBAR();
    #define PK(k) (bf16x8){lo[k][0],lo[k][1],lo[k][2],lo[k][3],hi[k][0],hi[k][1],hi[k][2],hi[k][3]}
    o[d0]=__builtin_amdgcn_mfma_f32_32x32x16_bf16(pa0,PK(0),o[d0],0,0,0);
    o[d0]=__builtin_amdgcn_mfma_f32_32x32x16_bf16(pa1,PK(1),o[d0],0,0,0);
    o[d0]=__builtin_amdgcn_mfma_f32_32x32x16_bf16(pa2,PK(2),o[d0],0,0,0);
    o[d0]=__builtin_amdgcn_mfma_f32_32x32x16_bf16(pa3,PK(3),o[d0],0,0,0);
    #undef PK
  }
}
struct AttnJob { const bf16* Q; const bf16* K; const bf16* V; bf16* O; int qp, kvp, op, NT, KR0, qb; const float* BT; };
#ifndef ATTN_STORE16
#define ATTN_STORE16(p,v) (*(u32x4*)(p)=(v))
#endif
template<int MODE,int THRL> __device__ __forceinline__ void attn_unit(const AttnJob&J,char*shm){
  const int tid=threadIdx.x,lane=tid&63,r32=lane&31,hi=lane>>5; const int wid=__builtin_amdgcn_readfirstlane(tid>>6);
  const int qp=J.qp,kvp=J.kvp,op=J.op,KR0=J.KR0;
  const bf16*Qw=J.Q+(long)(wid*QBLK)*qp;
  const unsigned lds0=(unsigned)(uintptr_t)shm;
  float*wsf=(float*)(shm+LDS_WS)+wid*64;
  const bf16*ksrc=J.K+(long)lane*kvp+wid*8;
  const bf16*vsrc=J.V+(long)(16*(wid&3)+(lane>>2))*kvp+(wid>>2)*32+(lane&3)*8;
  const unsigned kdst=lds0+LDS_K+wid*1024, vdst=lds0+LDS_V+wid*1024;
  #define TROW(t) ((MODE==1&&(t)>=4)?((t)+KR0)*KVBLK:(t)*KVBLK)
  #define DMA_K(t,slot) glds16(ksrc+(long)TROW(t)*kvp,(unsigned)__builtin_amdgcn_readfirstlane(kdst+(slot)))
  #define DMA_V(t,slot) glds16(vsrc+(long)TROW(t)*kvp,(unsigned)__builtin_amdgcn_readfirstlane(vdst+(slot)))
  const int vb0=(int)(lds0+LDS_V)+((lane>>4)&1)*32+(lane&3)*8+(4*hi+((lane&15)>>2))*64;
  const char*Kbase=shm+LDS_K; bf16x8 kf[8];
  const lds_cptr shm3=(lds_cptr)shm; const lds_cptr kp0=shm3+LDS_K+hi*1024+r32*16; const lds_cptr vp0=shm3+LDS_V+((lane>>4)&1)*32+(lane&3)*8+(4*hi+((lane&15)>>2))*64;
  const int NT=J.NT;
  const int qrow=4*J.qb+(wid>>1);
  const char*btsrc=(const char*)J.BT+(size_t)(((wid&1)*64+lane)*16);
  const unsigned btdst=lds0+LDS_BT+wid*8192;
  const lds_cptr btp=shm3+LDS_BT+wid*8192+lane*16;
  #define BTKIND(t) ((t)<4?NA_KIND_CTX:(((KR0+(t)-4)>=((qrow-4)<0?0:((qrow-4)>24?24:(qrow-4)))&&(KR0+(t)-4)<=((qrow-4)<0?0:((qrow-4)>24?24:(qrow-4)))+7)?(KR0+(t)-4-qrow+7):NA_KIND_NONE))
  #define DMA_BT(t) do{ if(MODE==1){ const char*s_=btsrc+(size_t)BTKIND(t)*16384; _Pragma("unroll") for(int j_=0;j_<8;++j_) glds16(s_+j_*2048,(unsigned)__builtin_amdgcn_readfirstlane(btdst+j_*1024)); } }while(0)
  #define BT_READ(C0,C1) do{ if(MODE==1){ _Pragma("unroll") for(int j_=0;j_<4;++j_){ const f32x4_t a_=*(const __attribute__((address_space(3))) f32x4_t*)(btp+j_*1024), b_=*(const __attribute__((address_space(3))) f32x4_t*)(btp+(j_+4)*1024); \
      C0[4*j_]=a_[0];C0[4*j_+1]=a_[1];C0[4*j_+2]=a_[2];C0[4*j_+3]=a_[3]; C1[4*j_]=b_[0];C1[4*j_+1]=b_[1];C1[4*j_+2]=b_[2];C1[4*j_+3]=b_[3]; } } }while(0)
  DMA_K(0,0);DMA_V(0,0);DMA_K(1,SLOTB);
  bf16x8 qr[4];
  #pragma unroll
  for(int d0=0;d0<4;++d0)qr[d0]=*reinterpret_cast<const bf16x8*>(&Qw[(long)r32*qp+d0*16+hi*8]);
  float mhat=0.f,l_reg=0.f;f32x16 o[2];o[0]=f32x16{};o[1]=f32x16{};f32x16 negm=f32x16{};if(MODE==0)asm volatile("":"+v"(negm));
  #define CMASK(P0,P1,t) do{ if(MODE==1){ _Pragma("unroll") for(int r=0;r<16;++r){P0[r]-=mhat;P1[r]-=mhat;} } }while(0)
  bool resc=false;
  #define START(P0,P1) do{ const float rm=rowmax(P0,P1); resc=false; \
    { const float dl=rm; mhat=fadd_s(mhat,dl); \
      _Pragma("unroll") for(int r=0;r<16;++r){P0[r]=fsub_s(P0[r],dl);P1[r]=fsub_s(P1[r],dl);} \
      if(MODE==0){ _Pragma("unroll") for(int r=0;r<16;++r)negm[r]=-mhat; asm volatile("":"+v"(negm)); } } \
    _Pragma("unroll") for(int r=0;r<16;++r)P0[r]=__builtin_amdgcn_exp2f(P0[r]); }while(0)
  #define RESC() do{ if(resc){ asm volatile("s_waitcnt lgkmcnt(0)":::"memory"); \
      _Pragma("unroll") for(int d_=0;d_<2;++d_) _Pragma("unroll") for(int r=0;r<16;++r)o[d_][r]*=wsf[crow(r,hi)]; } }while(0)
  f32x16 pA0,pA1,pB0,pB1;
  int sl_prev=0,sl_cur=0,sl_next=SLOTB;
  #define ROT() do{sl_prev=sl_cur;sl_cur=sl_next;sl_next=(sl_next==(NSLOT-1)*SLOTB)?0:sl_next+SLOTB;}while(0)
  DMA_K(2,2*SLOTB);
  WAIT_BAR(3);
  qkt(pA0,pA1,Kbase,qr,negm,r32,hi);asm volatile("s_nop 15\n\ts_nop 7":"+v"(pA0),"+v"(pA1));
  START(pA0,pA1);
  _Pragma("unroll") for(int r=0;r<16;++r)pA1[r]=__builtin_amdgcn_exp2f(pA1[r]);
  WAIT_BAR(0);
  DMA_BT(1);DMA_K(3,0);DMA_V(1,SLOTB);
  ROT();
  kload8(kf,kp0+sl_cur);
  WAIT_BAR(2);
  s16x4 vlo[8],vhi[8]; u32x4 pw0,pw1,pw2,pw3;
  #define PKW(P,B) cvtpk_s(P[B],P[B+1])
  #define PAF(k) __builtin_bit_cast(bf16x8,pw##k)
  #define VFR(i) (bf16x8){vlo[i][0],vlo[i][1],vlo[i][2],vlo[i][3],vhi[i][0],vhi[i][1],vhi[i][2],vhi[i][3]}
  #define PIN(x) asm volatile("":"+v"(x))
  #define MX3(a,b,c) __builtin_fmaxf(__builtin_fmaxf((a),(b)),(c))
  #define GAPA(MF,A0,A1,A2,A3,W0,W1,PW) do{ MF; sacc+=A0; sacc+=A1; sacc+=A2; sacc+=A3; PIN(sacc); W0; W1; PIN(PW); SBAR(); }while(0)
  #define EX(v) __builtin_amdgcn_exp2f(v)
  #define GAPB(MF,X,B) do{ MF; X[B]=EX(X[B]); X[B+1]=EX(X[B+1]); X[B+2]=EX(X[B+2]); X[B+3]=EX(X[B+3]); PIN(X); SBAR(); }while(0)
  #define VRD(i) do{ vlo[i]=vtr(vp_+(((i)>>2)*4096+((i)&3)*1024)); vhi[i]=vtr(vp_+(((i)>>2)*4096+((i)&3)*1024+512)); }while(0)
  #define KRD(G,j) do{ if(G){ kload2(kf,kp0+sl_next,j); SBAR(); } }while(0)
  #define STEP(C0,C1,P0,P1,t,GK,GV,GL) do{ SBAR(); \
    const lds_cptr vp_=vp0+sl_prev; \
    BT_READ(C0,C1); VRD(0); SBAR(); float sacc=(P0[0]+P0[1]); \
    GAPA(C0=__builtin_amdgcn_mfma_f32_32x32x16_bf16(kf[0],qr[0],(MODE==1?C0:negm),0,0,0), P0[2],P0[3],P0[4],P0[5],     pw0[0]=PKW(P0,0), pw0[1]=PKW(P0,2), pw0); \
    VRD(4); SBAR(); GAPA(C1=__builtin_amdgcn_mfma_f32_32x32x16_bf16(kf[1],qr[0],(MODE==1?C1:negm),0,0,0), P0[6],P0[7],P0[8],P0[9],     pw0[2]=PKW(P0,4), pw0[3]=PKW(P0,6), pw0); \
    VRD(1); SBAR(); GAPA(C0=__builtin_amdgcn_mfma_f32_32x32x16_bf16(kf[2],qr[1],C0,0,0,0),   P0[10],P0[11],P0[12],P0[13], pw1[0]=PKW(P0,8), pw1[1]=PKW(P0,10), pw1); \
    VRD(5); SBAR(); GAPA(C1=__builtin_amdgcn_mfma_f32_32x32x16_bf16(kf[3],qr[1],C1,0,0,0),   P0[14],P0[15],P1[0],P1[1],   pw1[2]=PKW(P0,12),pw1[3]=PKW(P0,14), pw1); \
    VRD(2); SBAR(); GAPA(C0=__builtin_amdgcn_mfma_f32_32x32x16_bf16(kf[4],qr[2],C0,0,0,0),   P1[2],P1[3],P1[4],P1[5],     pw2[0]=PKW(P1,0), pw2[1]=PKW(P1,2), pw2); \
    VRD(6); SBAR(); GAPA(C1=__builtin_amdgcn_mfma_f32_32x32x16_bf16(kf[5],qr[2],C1,0,0,0),   P1[6],P1[7],P1[8],P1[9],     pw2[2]=PKW(P1,4), pw2[3]=PKW(P1,6), pw2); \
    VRD(3); SBAR(); GAPA(C0=__builtin_amdgcn_mfma_f32_32x32x16_bf16(kf[6],qr[3],C0,0,0,0),   P1[10],P1[11],P1[12],P1[13], pw3[0]=PKW(P1,8), pw3[1]=PKW(P1,10), pw3); \
    VRD(7); SBAR(); GAPA(C1=__builtin_amdgcn_mfma_f32_32x32x16_bf16(kf[7],qr[3],C1,0,0,0),   P1[14],P1[15],0.f,0.f,       pw3[2]=PKW(P1,12),pw3[3]=PKW(P1,14), pw3); \
    l_reg+=sacc; \
    if(GV){DMA_BT((t)+1);} if(GK){DMA_K((t)+3,sl_cur);} if(GV){DMA_V((t)+1,sl_next);} \
    CMASK(C0,C1,t); \
    { float a=MX3(C0[0],C0[1],C1[0]),b=MX3(C0[2],C0[3],C1[1]); a=MX3(a,C1[2],C1[3]); \
      _Pragma("unroll") for(int r=4;r<16;r+=4){a=MX3(a,C0[r],C0[r+1]);b=MX3(b,C0[r+2],C0[r+3]);a=MX3(a,C1[r],C1[r+1]);b=MX3(b,C1[r+2],C1[r+3]);} \
      float rm=__builtin_fmaxf(a,b); { auto rr=__builtin_amdgcn_permlane32_swap(__float_as_uint(rm),__float_as_uint(rm),false,false); rm=__builtin_fmaxf(__uint_as_float(rr[0]),__uint_as_float(rr[1])); } \
      resc=false; \
      if(__builtin_expect(__any(rm>(float)THRL),0)){ const float dl=__builtin_fmaxf(rm,0.f); mhat+=dl; \
        _Pragma("unroll") for(int r=0;r<16;++r){C0[r]-=dl;C1[r]-=dl;} \
        if(MODE==0){ _Pragma("unroll") for(int r=0;r<16;++r)negm[r]=-mhat; asm volatile("":"+v"(negm)); } \
        const float f=__builtin_amdgcn_exp2f(-dl); l_reg*=f; if(hi==0)wsf[r32]=f; resc=true; } } \
    SBAR(); \
    GAPB(o[0]=__builtin_amdgcn_mfma_f32_32x32x16_bf16(PAF(0),VFR(0),o[0],0,0,0), C0,0); \
    GAPB(o[1]=__builtin_amdgcn_mfma_f32_32x32x16_bf16(PAF(0),VFR(4),o[1],0,0,0), C0,4); \
    KRD(GL,0); GAPB(o[0]=__builtin_amdgcn_mfma_f32_32x32x16_bf16(PAF(1),VFR(1),o[0],0,0,0), C0,8); \
    KRD(GL,1); GAPB(o[1]=__builtin_amdgcn_mfma_f32_32x32x16_bf16(PAF(1),VFR(5),o[1],0,0,0), C0,12); \
    KRD(GL,2); GAPB(o[0]=__builtin_amdgcn_mfma_f32_32x32x16_bf16(PAF(2),VFR(2),o[0],0,0,0), C1,0); \
    KRD(GL,3); GAPB(o[1]=__builtin_amdgcn_mfma_f32_32x32x16_bf16(PAF(2),VFR(6),o[1],0,0,0), C1,4); \
    GAPB(o[0]=__builtin_amdgcn_mfma_f32_32x32x16_bf16(PAF(3),VFR(3),o[0],0,0,0), C1,8); \
    GAPB(o[1]=__builtin_amdgcn_mfma_f32_32x32x16_bf16(PAF(3),VFR(7),o[1],0,0,0), C1,12); \
    }while(0)
  int t=1;
  for(;t+5<NT;t+=2){
    STEP(pB0,pB1,pA0,pA1,t,true,true,true);     WAIT_BAR(2); RESC(); ROT();
    STEP(pA0,pA1,pB0,pB1,t+1,true,true,true);   WAIT_BAR(2); RESC(); ROT();
  }
  #define ENDW(tt) do{ if((tt)+3<NT){WAIT_BAR(2);} else if((tt)+2<NT){WAIT_BAR(1);} else {WAIT_BAR(0);} }while(0)
  for(;t+1<NT;t+=2){
    STEP(pB0,pB1,pA0,pA1,t,(t+3<NT),(t+1<NT),(t+1<NT));       ENDW(t);   RESC(); ROT();
    STEP(pA0,pA1,pB0,pB1,t+1,(t+4<NT),(t+2<NT),(t+2<NT));     ENDW(t+1); RESC(); ROT();
  }
  STEP(pB0,pB1,pA0,pA1,NT-1,false,false,false); RESC();
  { float sacc=pB0[0]+pB0[1]; _Pragma("unroll") for(int r=2;r<16;++r)sacc+=pB0[r]; _Pragma("unroll") for(int r=0;r<16;++r)sacc+=pB1[r]; l_reg+=sacc;
    pw0=(u32x4){PKW(pB0,0),PKW(pB0,2),PKW(pB0,4),PKW(pB0,6)};pw1=(u32x4){PKW(pB0,8),PKW(pB0,10),PKW(pB0,12),PKW(pB0,14)};pw2=(u32x4){PKW(pB1,0),PKW(pB1,2),PKW(pB1,4),PKW(pB1,6)};pw3=(u32x4){PKW(pB1,8),PKW(pB1,10),PKW(pB1,12),PKW(pB1,14)};
    SBAR(); pv(o,vb0+sl_cur,PAF(0),PAF(1),PAF(2),PAF(3)); }
  #undef PKW
  #undef PAF
  #undef VFR
  #undef PIN
  #undef MX3
  #undef GAPA
  #undef GAPB
  #undef EX
  #undef VRD
  #undef KRD
  #undef STEP
  #undef ENDW
  {auto rr=__builtin_amdgcn_permlane32_swap(__float_as_uint(l_reg),__float_as_uint(l_reg),false,false);l_reg=__uint_as_float(rr[0])+__uint_as_float(rr[1]);}
  if(hi==0)wsf[32+r32]=l_reg;asm volatile("s_waitcnt lgkmcnt(0)":::"memory");
  float rli[16];
  #pragma unroll
  for(int r=0;r<16;++r)rli[r]=__builtin_amdgcn_rcpf(wsf[32+crow(r,hi)]);
  bf16*Ow=J.O+(long)(wid*QBLK)*op;
  { bf16*stg=(bf16*)(shm+LDS_OST)+wid*2048;
    #pragma unroll
    for(int r=0;r<16;++r){const int orow=crow(r,hi);
      #pragma unroll
      for(int d0=0;d0<2;++d0)stg[orow*64+d0*32+r32]=__float2bfloat16(o[d0][r]*rli[r]);}
    asm volatile("s_waitcnt lgkmcnt(0)":::"memory");
    #pragma unroll
    for(int i=0;i<4;++i){const int row=i*8+(lane>>3),ch=lane&7; const u32x4 v=*(const u32x4*)(stg+row*64+ch*8); ATTN_STORE16(Ow+(long)row*op+ch*8,v);} }
  asm volatile("s_waitcnt lgkmcnt(0)\n\ts_barrier":::"memory");
  #undef DMA_K
  #undef DMA_V
  #undef TROW
  #undef CMASK
  #undef BTKIND
  #undef DMA_BT
  #undef BT_READ
  #undef START
  #undef RESC
  #undef ROT
}
#undef SBAR
#undef WAIT_BAR
}

constexpr int NWAVES = 8;
constexpr int D = 1024, NB = 32, SEQ = 2048, CTXL = 256, TPB = SEQ + CTXL, M = NB * TPB, NPAN = M / 256, MLAT = NB * SEQ;
constexpr int DFF = 2816, DFE = 3584, NEXP = 8;
constexpr float EPSN = 1e-6f, LOG2E = 1.4426950408889634f, C2 = 0.125f * LOG2E;
constexpr int NPH = 22;

constexpr size_t MiB = 1u << 20;
constexpr size_t WS_CTL = 0, CTL_ZERO_BYTES = 1 * MiB;
constexpr size_t WS_MOD = 1 * MiB;
constexpr size_t WS_ROPE = 3 * MiB;
constexpr size_t WS_TKE = 4 * MiB;
constexpr size_t WS_TKR = WS_TKE + 512 * 1024;
constexpr size_t WS_TKW = WS_TKR + 512 * 1024;
constexpr size_t WS_STOK = WS_TKW + 512 * 1024;
constexpr size_t WS_SW = WS_STOK + 640 * 1024;
constexpr size_t WS_L16 = WS_SW + 640 * 1024;
constexpr size_t WS_WFT = 8 * MiB, WS_WQKVE = 10 * MiB, WS_WOE = 13 * MiB, WS_W13E = 15 * MiB, WS_W2E = 26 * MiB, WS_WINO = 32 * MiB, WS_WOO = 35 * MiB,
                 WS_GLUW = 37 * MiB, WS_PST = 38 * MiB, WS_MQT = 40 * MiB, WS_D256L = 44 * MiB, WS_D256C = WS_D256L + 512 * 1024, WS_FC = WS_D256L + 1024 * 1024, WS_TWD = WS_D256L + 1536 * 1024, WS_EW13 = 61 * MiB, WS_EW2 = 173 * MiB;
constexpr size_t WS_XC = 229 * MiB, WS_HN = 261 * MiB, WS_R = 405 * MiB;
constexpr size_t WS_H1 = WS_R, WS_OE = WS_R + 216 * MiB, WS_TT = WS_R + 360 * MiB, WS_UTC = WS_R + 440 * MiB, WS_UTL = WS_R + 448 * MiB, WS_VT = WS_R + 448 * MiB;
constexpr size_t WS_O = WS_R + 360 * MiB;
constexpr size_t WS_HMID = WS_R;
constexpr size_t WS_AB = WS_R + 180 * MiB, WS_S = WS_R + 252 * MiB, WS_Z = WS_R + 324 * MiB;
constexpr size_t WS_HNG = WS_R, WS_HME = WS_R + 132 * MiB;
constexpr size_t WS_BTG = 999 * MiB;
constexpr size_t WS_END = 1002 * MiB;
static_assert(WS_VT + 144 * MiB <= WS_END && WS_L16 + 16384 <= WS_WFT && WS_EW2 + 56 * MiB <= WS_XC && WS_O + 144 * MiB <= WS_END && WS_HME + 462 * MiB <= WS_END, "ws map");
constexpr int H1E_P = 1536, H1O_P = 1280;
constexpr int MAXSLOT = 135168;
constexpr int CW_TMO = 0, CW_BAR = 4096, CW_MOE = 200000  , CW_PEXP = 210000  , CW_CHUNK = 212000  , CW_FLAG = 214000  ;

constexpr int RING_OFF = 0, RING_BYTES = 131072;
constexpr int LDSCTL_OFF = 154112, MISC_OFF = LDSCTL_OFF + 320;
constexpr int LDS_BYTES = 163840;

#define GAS __attribute__((address_space(1)))
#define LAS __attribute__((address_space(3)))
typedef unsigned short bf16;
typedef unsigned v4u __attribute__((ext_vector_type(4)));
typedef unsigned v2u __attribute__((ext_vector_type(2)));
typedef float f32x4 __attribute__((ext_vector_type(4)));
typedef float f32x2 __attribute__((ext_vector_type(2)));
typedef GAS unsigned gu32;
#define RLX_AGENT __ATOMIC_RELAXED, __HIP_MEMORY_SCOPE_AGENT
#define LDS_WAIT() asm volatile("s_waitcnt lgkmcnt(0)" ::: "memory")
#define VM_WAIT() asm volatile("s_waitcnt vmcnt(0)" ::: "memory")
__device__ __forceinline__ unsigned f2bf(float f) { unsigned u = __builtin_bit_cast(unsigned, f); return (u + 0x7fffu + ((u >> 16) & 1u)) >> 16; }
__device__ __forceinline__ unsigned pk2(float lo, float hi) { return f2bf(lo) | (f2bf(hi) << 16); }
__device__ __forceinline__ float bflo(unsigned w) { return __uint_as_float(w << 16); }
__device__ __forceinline__ float bfhi(unsigned w) { return __uint_as_float(w & 0xffff0000u); }
__device__ __forceinline__ f32x4 bf4_to_f32(v2u w) { f32x4 r; r.x = bflo(w.x); r.y = bfhi(w.x); r.z = bflo(w.y); r.w = bfhi(w.y); return r; }
__device__ __forceinline__ float fast_exp(float x) { return __builtin_amdgcn_exp2f(x * LOG2E); }
__device__ __forceinline__ float sigmoidf_(float x) { return __builtin_amdgcn_rcpf(1.0f + fast_exp(-x)); }
__device__ __forceinline__ float siluf_(float x) { return x * sigmoidf_(x); }
__device__ __forceinline__ unsigned pk4_fp8(float a, float b, float c, float d);
__device__ __forceinline__ float gelu_tanh(float x) { const float u = 0.7978845608028654f * (x + 0.044715f * x * x * x); return x * sigmoidf_(2.0f * u); }

#define XB_TMO      128
#define XB_XCNT(j)  (256  + 64 * (j))
#define XB_XSUB(j)  (1280 + 64 * (j))
#define XB_XGEN(j)  (2304 + 64 * (j))
#define XB_TOP      3328
#define XB_TOPGEN   3392
#define XCD_BAR_WORDS 3456
#define XB_SPIN_CAP (1u << 18)
__device__ __forceinline__ unsigned xb_ld(unsigned* p)              { return __hip_atomic_load(p, __ATOMIC_RELAXED, __HIP_MEMORY_SCOPE_AGENT); }
__device__ __forceinline__ unsigned xb_add(unsigned* p, unsigned v) { return __hip_atomic_fetch_add(p, v, __ATOMIC_RELAXED, __HIP_MEMORY_SCOPE_AGENT); }
__device__ __forceinline__ unsigned xb_xcc_id() { return (unsigned)__builtin_amdgcn_s_getreg((3 << 11) | 20) & 0xFu; }
#define XB_SPIN(cond, bar) do { unsigned _sp = 0; while (cond) { __builtin_amdgcn_s_sleep(1); \
    if ((++_sp & 255u) == 0u) { if (xb_ld(&(bar)[XB_TMO])) break; if (_sp > XB_SPIN_CAP) { atomicAdd(&(bar)[XB_TMO], 1u); break; } } } } while (0)
struct XcdBarrier { unsigned* bar; unsigned x; volatile LAS unsigned* st; };
__device__ __forceinline__ XcdBarrier xcd_barrier_post(unsigned* bar, volatile LAS unsigned* st) {
    XcdBarrier b; b.bar = bar; b.x = xb_xcc_id(); b.st = st;
    if (threadIdx.x == 0) (void)xb_add(&bar[XB_XCNT(b.x)], 1u);
    return b;
}
__device__ __forceinline__ void xcd_barrier_complete(unsigned* bar, unsigned x, unsigned& nloc, unsigned& nx) {
    const unsigned G = gridDim.x * gridDim.y * gridDim.z;
    unsigned sum, cnt, mine, sp = 0u;
    for (;;) {
        sum = 0u; cnt = 0u; mine = 0u;
#pragma unroll
        for (unsigned j = 0; j < 16; ++j) { const unsigned c = xb_ld(&bar[XB_XCNT(j)]); sum += c; cnt += (c > 0u) ? 1u : 0u; mine = (j == x) ? c : mine; }
        if (sum == G) break;
        __builtin_amdgcn_s_sleep(1);
        if ((++sp & 255u) == 0u) { if (xb_ld(&bar[XB_TMO])) break; if (sp > XB_SPIN_CAP) { atomicAdd(&bar[XB_TMO], 1u); break; } }
    }
    nloc = mine > 0u ? mine : 1u; nx = cnt > 0u ? cnt : 1u;
}
__device__ __forceinline__ void xcd_barrier(const XcdBarrier& b) {
    asm volatile("s_waitcnt vmcnt(0)" ::: "memory");
    __syncthreads();
    if (threadIdx.x == 0) {
        unsigned* bar = b.bar;
        __builtin_amdgcn_s_waitcnt(0);
        unsigned nloc = b.st[0], nx = b.st[1];
        if (nloc == 0u) { xcd_barrier_complete(bar, b.x, nloc, nx); b.st[0] = nloc; b.st[1] = nx; }
        const unsigned old = xb_add(&bar[XB_XSUB(b.x)], 1u);
        const unsigned gen = old / nloc;
        if (old + 1u == (gen + 1u) * nloc) {
            __builtin_amdgcn_fence(__ATOMIC_RELEASE, "agent");
            asm volatile("s_waitcnt vmcnt(0)" ::: "memory");
            const unsigned og = xb_add(&bar[XB_TOP], 1u);
            const unsigned tg = og / nx;
            if (og + 1u == (tg + 1u) * nx) xb_add(&bar[XB_TOPGEN], 1u);
            else XB_SPIN(xb_ld(&bar[XB_TOPGEN]) == tg, bar);
            __builtin_amdgcn_fence(__ATOMIC_ACQUIRE, "agent");
            xb_add(&bar[XB_XGEN(b.x)], 1u);
            asm volatile("s_waitcnt vmcnt(0)" ::: "memory");
        } else {
            XB_SPIN(xb_ld(&bar[XB_XGEN(b.x)]) == gen, bar);
            __builtin_amdgcn_fence(__ATOMIC_ACQUIRE, "agent");
            asm volatile("s_waitcnt vmcnt(0)" ::: "memory");
        }
    }
    __syncthreads();
}

struct Frame {
    LAS unsigned char* lds;
    volatile LAS unsigned* MISC;
    unsigned* ctl;
    int tid, lane, wave, vcu, G;
    const float* const* in;
    unsigned char* ws;
    bf16* XL; bf16* XC; float* OUT; bf16* X3P;
};
__device__ __forceinline__ float wave_sum(float v) {
#pragma unroll
    for (int o = 1; o < 64; o <<= 1) v += __shfl_xor(v, o);
    return v;
}
template <class T> __device__ __forceinline__ T* wsp(const Frame& F, size_t off) { return (T*)(F.ws + off); }
__device__ __forceinline__ const float* modp(const Frame& F, int layer, int bidx, int chunk) { return wsp<const float>(F, WS_MOD) + ((size_t)(layer * 33 + bidx) * 6 + chunk) * 1024; }

using pg8::Unit; using pg8::cvt_pk_bf16;
typedef pg8::f32x4 (&AccRef)[2][2][4][2];
#define EPI_FOR_ROWS _Pragma("unroll") for (int ai = 0; ai < 2; ++ai) _Pragma("unroll") for (int m = 0; m < 4; ++m)

struct EpiPlainBf16 {
    static constexpr bool PERM = true;
    bf16* O; int ldc, zrows, rowoff, zcols;
    __device__ __forceinline__ void operator()(const pg8::f32x4 (&acc)[2][2][4][2], const Unit& u, int wr, int wc, int fr, int fq) const {
        const size_t row0 = (size_t)u.z * zrows + rowoff + u.pm * 256 + wr * 64 + fr; const int col0 = u.z * zcols + u.pn * 256 + wc * 32 + 8 * fq;
        EPI_FOR_ROWS { bf16* rowp = O + (row0 + ai * 128 + m * 16) * ldc + col0;
#pragma unroll
            for (int bj = 0; bj < 2; ++bj) { const pg8::f32x4 v0 = acc[ai][bj][m][0], v1 = acc[ai][bj][m][1];
                v4u w; w.x = cvt_pk_bf16(v0[0], v0[1]); w.y = cvt_pk_bf16(v0[2], v0[3]); w.z = cvt_pk_bf16(v1[0], v1[1]); w.w = cvt_pk_bf16(v1[2], v1[3]);
                *(v4u*)(rowp + bj * 128) = w; } }
    }
};
struct EpiFourT {
    static constexpr bool PERM = true;
    bf16* UTL; bf16* UTC;
    __device__ __forceinline__ void operator()(const pg8::f32x4 (&acc)[2][2][4][2], const Unit& u, int wr, int wc, int fr, int fq) const {
        const int b = u.pn / 9, tp = u.pn % 9; const int col0 = wc * 32 + 8 * fq;
        EPI_FOR_ROWS { const int ch = u.pm * 256 + ai * 128 + wr * 64 + m * 16 + fr;
            bf16* rowp = (tp == 0) ? UTC + ((size_t)(b * 512 + ch) * 256 + col0) : UTL + ((size_t)(b * 512 + ch) * 2048 + (tp - 1) * 256 + col0);
#pragma unroll
            for (int bj = 0; bj < 2; ++bj) { const pg8::f32x4 v0 = acc[ai][bj][m][0], v1 = acc[ai][bj][m][1];
                v4u w; w.x = cvt_pk_bf16(v0[0], v0[1]); w.y = cvt_pk_bf16(v0[2], v0[3]); w.z = cvt_pk_bf16(v1[0], v1[1]); w.w = cvt_pk_bf16(v1[2], v1[3]);
                *(v4u*)(rowp + bj * 128) = w; } }
    }
};
struct EpiVT {
    static constexpr bool PERM = true;
    bf16* VT; int lat;
    __device__ __forceinline__ void operator()(const pg8::f32x4 (&acc)[2][2][4][2], const Unit& u, int wr, int wc, int fr_, int fq_) const {
        int tl = threadIdx.x; asm volatile("" : "+v"(tl)); const int fr = tl & 15, fq = (tl >> 4) & 3;
        const int b = lat ? u.z / 5 : u.z, k1 = lat ? u.z % 5 : 0, kstr = lat ? 8 : 1, ri = u.pm; const size_t rowbase = (size_t)b * TPB + (lat ? CTXL : 0);
        const bool mir = lat && k1 >= 1 && k1 <= 3; const unsigned sgn = ri ? 0x80008000u : 0u;
        const int cbase = u.pn * 512 + ri * 128 + wc * 32 + 8 * fq;
        EPI_FOR_ROWS { const int k2 = ai * 128 + wr * 64 + m * 16 + fr; bf16* rowp = VT + (rowbase + k1 + kstr * k2) * 1024 + cbase;
#pragma unroll
            for (int bj = 0; bj < 2; ++bj) { const pg8::f32x4 v0 = acc[ai][bj][m][0], v1 = acc[ai][bj][m][1];
                v4u w; w.x = cvt_pk_bf16(v0[0], v0[1]); w.y = cvt_pk_bf16(v0[2], v0[3]); w.z = cvt_pk_bf16(v1[0], v1[1]); w.w = cvt_pk_bf16(v1[2], v1[3]);
                *(v4u*)(rowp + bj * 256) = w; }
            asm volatile("" ::: "memory"); }
        if (mir) { EPI_FOR_ROWS { const int k2 = ai * 128 + wr * 64 + m * 16 + fr; bf16* rowp = VT + (rowbase + (8 - k1) + 8 * (255 - k2)) * 1024 + cbase;
#pragma unroll
            for (int bj = 0; bj < 2; ++bj) { const pg8::f32x4 v0 = acc[ai][bj][m][0], v1 = acc[ai][bj][m][1];
                v4u w; w.x = cvt_pk_bf16(v0[0], v0[1]) ^ sgn; w.y = cvt_pk_bf16(v0[2], v0[3]) ^ sgn; w.z = cvt_pk_bf16(v1[0], v1[1]) ^ sgn; w.w = cvt_pk_bf16(v1[2], v1[3]) ^ sgn;
                *(v4u*)(rowp + bj * 256) = w; }
            asm volatile("" ::: "memory"); } }
    }
};
struct EpiOddIn {
    static constexpr bool PERM = true;
    bf16* H1; bf16* AB;
    __device__ __forceinline__ void operator()(const pg8::f32x4 (&acc)[2][2][4][2], const Unit& u, int wr, int wc, int fr, int fq) const {
        const int row0 = u.pm * 256 + wr * 64 + fr, cl0 = wc * 32 + 8 * fq;
        EPI_FOR_ROWS { const int row = row0 + ai * 128 + m * 16;
#pragma unroll
            for (int bj = 0; bj < 2; ++bj) { const pg8::f32x4 v0 = acc[ai][bj][m][0], v1 = acc[ai][bj][m][1];
                v4u w; w.x = cvt_pk_bf16(v0[0], v0[1]); w.y = cvt_pk_bf16(v0[2], v0[3]); w.z = cvt_pk_bf16(v1[0], v1[1]); w.w = cvt_pk_bf16(v1[2], v1[3]);
                const int cl = cl0 + bj * 128;
                if (u.pn < 5) *(v4u*)(H1 + (size_t)row * H1O_P + u.pn * 256 + cl) = w;
                else { const int g = cl >> 4, n0 = cl & 15; *(v4u*)(AB + ((size_t)(g * 4608 + (row >> 4)) * 512 + (row & 15) * 16 + n0)) = w; } } }
    }
};
template <bool ODD> struct EpiQKV {
    static constexpr bool PERM = true;
    bf16* H1; bf16* AB; const float* qg; const float* kg; const float* rc; const float* rs; LAS float* xch; float s; int pn0;
    __device__ __forceinline__ void operator()(const pg8::f32x4 (&acc)[2][2][4][2], const Unit& u, int wr, int wc, int fr_, int fq_) const {
        int tl = threadIdx.x; asm volatile("" : "+v"(tl)); const int fr = tl & 15, fq = (tl >> 4) & 3; const int wid = wr * 4 + wc;
        constexpr int P = ODD ? H1O_P : H1E_P;
        const int row0 = u.pm * 256 + wr * 64 + fr, cl0 = wc * 32 + 8 * fq;
        const int upn = u.pn + pn0;
        const bool normtile = ODD ? (upn <= 3) : (upn <= 3);
        if (!normtile) {
            EPI_FOR_ROWS { const int row = row0 + ai * 128 + m * 16;
#pragma unroll
                for (int bj = 0; bj < 2; ++bj) { const pg8::f32x4 v0 = acc[ai][bj][m][0] * s, v1 = acc[ai][bj][m][1] * s;
                    v4u w; w.x = cvt_pk_bf16(v0[0], v0[1]); w.y = cvt_pk_bf16(v0[2], v0[3]); w.z = cvt_pk_bf16(v1[0], v1[1]); w.w = cvt_pk_bf16(v1[2], v1[3]);
                    const int cl = cl0 + bj * 128;
                    if (!ODD || upn < 5) *(v4u*)(H1 + (size_t)row * P + upn * 256 + cl) = w;
                    else { const int g = cl >> 4, n0 = cl & 15; *(v4u*)(AB + ((size_t)(g * 4608 + (row >> 4)) * 512 + (row & 15) * 16 + n0)) = w; } } }
            return; }
        float ss[2][4][2];
        EPI_FOR_ROWS {
#pragma unroll
            for (int bj = 0; bj < 2; ++bj) { const pg8::f32x4 v0 = acc[ai][bj][m][0] * this->s, v1 = acc[ai][bj][m][1] * this->s;
                float s = (v0[0] * v0[0] + v0[1] * v0[1]) + (v0[2] * v0[2] + v0[3] * v0[3]) + (v1[0] * v1[0] + v1[1] * v1[1]) + (v1[2] * v1[2] + v1[3] * v1[3]);
                s += __shfl_xor(s, 16); s += __shfl_xor(s, 32); ss[ai][m][bj] = s; } }
        if (fq == 0) { EPI_FOR_ROWS {
#pragma unroll
            for (int bj = 0; bj < 2; ++bj) xch[((wid * 8 + ai * 4 + m) * 2 + bj) * 16 + fr] = ss[ai][m][bj]; } }
        asm volatile("s_waitcnt lgkmcnt(0)" ::: "memory"); __builtin_amdgcn_s_barrier(); asm volatile("" ::: "memory");
        EPI_FOR_ROWS {
#pragma unroll
            for (int bj = 0; bj < 2; ++bj) ss[ai][m][bj] += xch[(((wid ^ 1) * 8 + ai * 4 + m) * 2 + bj) * 16 + fr]; }
        const int d0 = (wc & 1) * 32 + 8 * fq;
        const pg8::f32x4 gq0 = *(const pg8::f32x4*)(qg + d0) * C2, gq1 = *(const pg8::f32x4*)(qg + d0 + 4) * C2, gk0 = *(const pg8::f32x4*)(kg + d0), gk1 = *(const pg8::f32x4*)(kg + d0 + 4);
        const int tp = u.pm % 9;
        EPI_FOR_ROWS { const int rl = wr * 64 + fr + ai * 128 + m * 16; const int row = u.pm * 256 + rl;
            pg8::f32x4 c4 = {1.f, 1.f, 1.f, 1.f}, s4 = {0.f, 0.f, 0.f, 0.f};
            if (ODD && tp > 0) { const int n = (tp - 1) * 256 + rl; c4 = *(const pg8::f32x4*)(rc + n * 32 + (d0 >> 1)); s4 = *(const pg8::f32x4*)(rs + n * 32 + (d0 >> 1)); }
#pragma unroll
            for (int bj = 0; bj < 2; ++bj) { const int col = upn * 256 + bj * 128 + (wc >> 1) * 64;
                const int mode = ODD ? (col < 768 ? 0 : (col < 960 ? 1 : 2)) : (upn < 2 ? 0 : 1);
                pg8::f32x4 v0 = acc[ai][bj][m][0] * s, v1 = acc[ai][bj][m][1] * s;
                if (mode < 2) { const float rstd = __builtin_amdgcn_rsqf(ss[ai][m][bj] * (1.0f / 64.0f) + EPSN);
                    v0 = v0 * rstd * (mode == 0 ? gq0 : gk0); v1 = v1 * rstd * (mode == 0 ? gq1 : gk1);
                    if (ODD && tp > 0) { pg8::f32x4 a = v0, b = v1;
                        v0[0] = a[0] * c4[0] - a[1] * s4[0]; v0[1] = a[0] * s4[0] + a[1] * c4[0]; v0[2] = a[2] * c4[1] - a[3] * s4[1]; v0[3] = a[2] * s4[1] + a[3] * c4[1];
                        v1[0] = b[0] * c4[2] - b[1] * s4[2]; v1[1] = b[0] * s4[2] + b[1] * c4[2]; v1[2] = b[2] * c4[3] - b[3] * s4[3]; v1[3] = b[2] * s4[3] + b[3] * c4[3]; } }
                v4u w; w.x = cvt_pk_bf16(v0[0], v0[1]); w.y = cvt_pk_bf16(v0[2], v0[3]); w.z = cvt_pk_bf16(v1[0], v1[1]); w.w = cvt_pk_bf16(v1[2], v1[3]);
                *(v4u*)(H1 + (size_t)row * P + upn * 256 + bj * 128 + cl0) = w; }
            asm volatile("" ::: "memory"); }
    }
};
struct EpiPlainF32 {
    static constexpr bool PERM = false;
    float* C; int ldc, zrows;
    __device__ __forceinline__ void operator()(const pg8::f32x4 (&acc)[2][2][4][2], const Unit& u, int wr, int wc, int fr, int fq) const {
        const size_t row0 = (size_t)u.z * zrows + u.pm * 256 + wr * 64 + fr; const int col0 = u.pn * 256 + wc * 32 + 4 * fq;
        EPI_FOR_ROWS { float* rowp = C + (row0 + ai * 128 + m * 16) * ldc + col0;
#pragma unroll
            for (int bj = 0; bj < 2; ++bj)
#pragma unroll
                for (int n = 0; n < 2; ++n) *(pg8::f32x4*)(rowp + bj * 128 + n * 16) = acc[ai][bj][m][n]; }
    }
};
template <bool INF32> struct EpiResid {
    static constexpr bool PERM = true;
    const void* inL; const void* inC; bf16* outL; bf16* outC; const float* mod; int gchunk;
    __device__ __forceinline__ void operator()(const pg8::f32x4 (&acc)[2][2][4][2], const Unit& u, int wr, int wc, int fr_, int fq_) const {
        int tl = threadIdx.x; asm volatile("" : "+v"(tl)); const int fr = tl & 15, fq = (tl >> 4) & 3;
        const int b = u.pm / 9, tp = u.pm % 9;
        const float* gate = mod + ((size_t)(tp == 0 ? 32 : b) * 6 + gchunk) * 1024;
        const int col0 = u.pn * 256 + wc * 32 + 8 * fq;
        pg8::f32x4 gv[2][2];
#pragma unroll
        for (int bj = 0; bj < 2; ++bj)
#pragma unroll
            for (int n = 0; n < 2; ++n) gv[bj][n] = *(const pg8::f32x4*)(gate + col0 + bj * 128 + n * 4);
        const size_t rbase = (tp == 0) ? (size_t)(b * 256) * D : (size_t)(b * 2048 + (tp - 1) * 256) * D;
        const void* inp = (tp == 0) ? inC : inL; bf16* out = ((tp == 0) ? outC : outL) + rbase;
        const size_t off0 = (size_t)(wr * 64 + fr) * D + col0;
#pragma unroll
        for (int ai = 0; ai < 2; ++ai) {
            if (INF32) { pg8::f32x4 xin[4][2][2];
#pragma unroll
                for (int m = 0; m < 4; ++m)
#pragma unroll
                    for (int bj = 0; bj < 2; ++bj) { const float* in = (const float*)inp + rbase + off0 + (size_t)(ai * 128 + m * 16) * D + bj * 128; xin[m][bj][0] = *(const pg8::f32x4*)in; xin[m][bj][1] = *(const pg8::f32x4*)(in + 4); }
#pragma unroll
                for (int m = 0; m < 4; ++m)
#pragma unroll
                    for (int bj = 0; bj < 2; ++bj) { const pg8::f32x4 y0 = xin[m][bj][0] + gv[bj][0] * acc[ai][bj][m][0], y1 = xin[m][bj][1] + gv[bj][1] * acc[ai][bj][m][1];
                        v4u o; o.x = cvt_pk_bf16(y0[0], y0[1]); o.y = cvt_pk_bf16(y0[2], y0[3]); o.z = cvt_pk_bf16(y1[0], y1[1]); o.w = cvt_pk_bf16(y1[2], y1[3]);
                        *(v4u*)(out + off0 + (size_t)(ai * 128 + m * 16) * D + bj * 128) = o; }
            } else { v4u xin[4][2];
#pragma unroll
                for (int m = 0; m < 4; ++m)
#pragma unroll
                    for (int bj = 0; bj < 2; ++bj) xin[m][bj] = *(const v4u*)((const bf16*)inp + rbase + off0 + (size_t)(ai * 128 + m * 16) * D + bj * 128);
#pragma unroll
                for (int m = 0; m < 4; ++m)
#pragma unroll
                    for (int bj = 0; bj < 2; ++bj) { const v4u w = xin[m][bj];
                        const pg8::f32x4 x0 = (pg8::f32x4){bflo(w.x), bfhi(w.x), bflo(w.y), bfhi(w.y)}, x1 = (pg8::f32x4){bflo(w.z), bfhi(w.z), bflo(w.w), bfhi(w.w)};
                        const pg8::f32x4 y0 = x0 + gv[bj][0] * acc[ai][bj][m][0], y1 = x1 + gv[bj][1] * acc[ai][bj][m][1];
                        v4u o; o.x = cvt_pk_bf16(y0[0], y0[1]); o.y = cvt_pk_bf16(y0[2], y0[3]); o.z = cvt_pk_bf16(y1[0], y1[1]); o.w = cvt_pk_bf16(y1[2], y1[3]);
                        *(v4u*)(out + off0 + (size_t)(ai * 128 + m * 16) * D + bj * 128) = o; }
            }
            asm volatile("" ::: "memory"); }
    }
};
__device__ __forceinline__ unsigned pk4_fp8(float a, float b, float c, float d) {
    a = __builtin_amdgcn_fmed3f(a, -448.f, 448.f); b = __builtin_amdgcn_fmed3f(b, -448.f, 448.f); c = __builtin_amdgcn_fmed3f(c, -448.f, 448.f); d = __builtin_amdgcn_fmed3f(d, -448.f, 448.f);
    int w = 0; w = __builtin_amdgcn_cvt_pk_fp8_f32(a, b, w, false); w = __builtin_amdgcn_cvt_pk_fp8_f32(c, d, w, true); return (unsigned)w; }
template <bool F8> struct EpiSwiglu {
    static constexpr bool PERM = true;
    unsigned char* H; int ldh, local; float sa, sb;
    __device__ __forceinline__ void operator()(const pg8::f32x4 (&acc)[2][2][4][2], const Unit& u, int wr, int wc, int fr_, int fq_) const {
        int tl = threadIdx.x; asm volatile("" : "+v"(tl)); const int fr = tl & 15, fq = (tl >> 4) & 3;
        const size_t row0 = (size_t)(local ? u.aux : u.pm) * 256 + wr * 64 + fr; const int h0 = u.pn * 128 + wc * 32 + 8 * fq;
        typedef float f32x2_ __attribute__((ext_vector_type(2)));
        const float kx = -sa * LOG2E, ic = 1.0f / (sa * sb); const f32x2_ kexp = {kx, kx}, invc = {ic, ic};
        EPI_FOR_ROWS { float o[8];
#pragma unroll
            for (int n = 0; n < 2; ++n)
#pragma unroll
                for (int e = 0; e < 4; e += 2) { const f32x2_ a = {acc[ai][0][m][n][e], acc[ai][0][m][n][e + 1]}, b = {acc[ai][1][m][n][e], acc[ai][1][m][n][e + 1]};
                    const f32x2_ t = a * kexp; f32x2_ ex; ex.x = __builtin_amdgcn_exp2f(t.x); ex.y = __builtin_amdgcn_exp2f(t.y);
                    const f32x2_ d = ex * invc + invc; f32x2_ r; r.x = __builtin_amdgcn_rcpf(d.x); r.y = __builtin_amdgcn_rcpf(d.y);
                    const f32x2_ q = (a * b) * r; o[4 * n + e] = q.x; o[4 * n + e + 1] = q.y; }
            if (F8) { v2u w; w.x = pk4_fp8(o[0], o[1], o[2], o[3]); w.y = pk4_fp8(o[4], o[5], o[6], o[7]); __builtin_nontemporal_store(w, (v2u*)(H + (row0 + ai * 128 + m * 16) * ldh + h0)); }
            else { v4u w; w.x = cvt_pk_bf16(o[0], o[1]); w.y = cvt_pk_bf16(o[2], o[3]); w.z = cvt_pk_bf16(o[4], o[5]); w.w = cvt_pk_bf16(o[6], o[7]); __builtin_nontemporal_store(w, (v4u*)((bf16*)H + (row0 + ai * 128 + m * 16) * ldh + h0)); } }
    }
};
struct EpiS5B {
    static constexpr bool PERM = true;
    const bf16* AB; const float* dsk; bf16* Z;
    __device__ __forceinline__ void operator()(const pg8::f32x4 (&acc)[2][2][4][2], const Unit& u, int wr, int wc, int fr, int fq) const {
        const int g = u.z, cl0 = wc * 32 + 8 * fq;
        EPI_FOR_ROWS { const int cr = u.pm * 256 + ai * 128 + wr * 64 + m * 16 + fr, b = cr / 144, c = cr % 144;
            if (c >= 16) {
#pragma unroll
                for (int bj = 0; bj < 2; ++bj) { const int cl = cl0 + bj * 128, i = cl >> 4, m0 = cl & 15;
                    const v4u uu = *(const v4u*)(AB + ((size_t)(g * 4608 + cr) * 512 + cl));
                    const pg8::f32x4 d0 = *(const pg8::f32x4*)(dsk + g * 16 + m0), d1 = *(const pg8::f32x4*)(dsk + g * 16 + m0 + 4);
                    const pg8::f32x4 v0 = acc[ai][bj][m][0], v1 = acc[ai][bj][m][1];
                    float y[8];
                    y[0] = v0[0] + d0[0] * bflo(uu.x); y[1] = v0[1] + d0[1] * bfhi(uu.x); y[2] = v0[2] + d0[2] * bflo(uu.y); y[3] = v0[3] + d0[3] * bfhi(uu.y);
                    y[4] = v1[0] + d1[0] * bflo(uu.z); y[5] = v1[1] + d1[1] * bfhi(uu.z); y[6] = v1[2] + d1[2] * bflo(uu.w); y[7] = v1[3] + d1[3] * bfhi(uu.w);
#pragma unroll
                    for (int e = 0; e < 8; ++e) y[e] = gelu_tanh(y[e]);
                    v4u w; w.x = cvt_pk_bf16(y[0], y[1]); w.y = cvt_pk_bf16(y[2], y[3]); w.z = cvt_pk_bf16(y[4], y[5]); w.w = cvt_pk_bf16(y[6], y[7]);
                    *(v4u*)(Z + ((size_t)(b * TPB + 16 * c + i) * 256 + g * 16 + m0)) = w; } }
            asm volatile("" ::: "memory"); }
    }
};
struct EpiGLU {
    static constexpr bool PERM = true;
    const bf16* Z; const float* bias; bf16* O;
    __device__ __forceinline__ void operator()(const pg8::f32x4 (&acc)[2][2][4][2], const Unit& u, int wr, int wc, int fr, int fq) const {
        const int row0 = u.pm * 256 + wr * 64 + fr, cl0 = wc * 32 + 8 * fq;
        EPI_FOR_ROWS { const size_t row = (size_t)(row0 + ai * 128 + m * 16);
#pragma unroll
            for (int bj = 0; bj < 2; ++bj) { const int cl = cl0 + bj * 128;
                const v4u zz = *(const v4u*)(Z + row * 256 + cl);
                const pg8::f32x4 b0 = *(const pg8::f32x4*)(bias + cl), b1 = *(const pg8::f32x4*)(bias + cl + 4);
                const pg8::f32x4 v0 = acc[ai][bj][m][0] + b0, v1 = acc[ai][bj][m][1] + b1;
                v4u w; w.x = cvt_pk_bf16(bflo(zz.x) * sigmoidf_(v0[0]), bfhi(zz.x) * sigmoidf_(v0[1])); w.y = cvt_pk_bf16(bflo(zz.y) * sigmoidf_(v0[2]), bfhi(zz.y) * sigmoidf_(v0[3]));
                w.z = cvt_pk_bf16(bflo(zz.z) * sigmoidf_(v1[0]), bfhi(zz.z) * sigmoidf_(v1[1])); w.w = cvt_pk_bf16(bflo(zz.w) * sigmoidf_(v1[2]), bfhi(zz.w) * sigmoidf_(v1[3]));
                *(v4u*)(O + row * 1024 + 768 + cl) = w; }
            asm volatile("" ::: "memory"); }
    }
};
template <bool LASTH> struct EpiMoe2 {
    static constexpr bool PERM = true;
    const bf16* Xin; void* Xout; const int* stok; const float* sw; const float* mod;
    __device__ __forceinline__ void operator()(const pg8::f32x4 (&acc)[2][2][4][2], const Unit& u, int wr, int wc, int fr_, int fq_) const {
        int tl = threadIdx.x; asm volatile("" : "+v"(tl)); const int fr = tl & 15, fq = (tl >> 4) & 3;
        const int slot0 = u.pm * 256 + wr * 64 + fr, col0 = u.pn * 256 + wc * 32 + 8 * fq;
        int tok[2][4]; float wv[2][4];
        EPI_FOR_ROWS { const int slot = slot0 + ai * 128 + m * 16; tok[ai][m] = stok[slot]; wv[ai][m] = sw[slot] * (1.0f / 512.0f);   }
#pragma unroll
        for (int ai = 0; ai < 2; ++ai)
#pragma unroll
            for (int bj = 0; bj < 2; ++bj) { v4u xw[4]; pg8::f32x4 g0[4], g1[4];
#pragma unroll
                for (int m = 0; m < 4; ++m) { const int t = tok[ai][m] < 0 ? 0 : tok[ai][m]; const float* gate = mod + ((size_t)(t >> 11) * 6 + 5) * 1024 + col0 + bj * 128;
                    xw[m] = *(const v4u*)(Xin + (size_t)t * D + col0 + bj * 128); g0[m] = *(const pg8::f32x4*)gate; g1[m] = *(const pg8::f32x4*)(gate + 4); }
#pragma unroll
                for (int m = 0; m < 4; ++m) { if (tok[ai][m] >= 0) { const float w = wv[ai][m]; const size_t xo = (size_t)tok[ai][m] * D + col0 + bj * 128;
                    const pg8::f32x4 x0 = (pg8::f32x4){bflo(xw[m].x), bfhi(xw[m].x), bflo(xw[m].y), bfhi(xw[m].y)}, x1 = (pg8::f32x4){bflo(xw[m].z), bfhi(xw[m].z), bflo(xw[m].w), bfhi(xw[m].w)};
                    const pg8::f32x4 y0 = x0 + (g0[m] * w) * acc[ai][bj][m][0], y1 = x1 + (g1[m] * w) * acc[ai][bj][m][1];
                    if (LASTH) { float* o = (float*)Xout + xo; *(pg8::f32x4*)o = y0; *(pg8::f32x4*)(o + 4) = y1; }
                    else { v4u o; o.x = cvt_pk_bf16(y0[0], y0[1]); o.y = cvt_pk_bf16(y0[2], y0[3]); o.z = cvt_pk_bf16(y1[0], y1[1]); o.w = cvt_pk_bf16(y1[2], y1[3]); *(v4u*)((bf16*)Xout + xo) = o; } } }
                asm volatile("" ::: "memory"); }
    }
};

template <int MAP> __device__ __forceinline__ int map_row(int n) { return MAP == 0 ? n : (MAP == 1 ? (((n >> 7) << 8) + (n & 127)) : (((n >> 7) << 8) + 128 + (n & 127))); }
template <int MAP> __device__ __forceinline__ void tr_item(const float* W, int ldw, int col0, int K, int nblk, bf16* WT, int row_off, LAS float* scr, int item, int lane) {
    const int kb = item / nblk, nb = item % nblk, k0 = 64 * kb, n0 = 32 * nb;
#pragma unroll 8
    for (int i = 0; i < 32; ++i) { const int kk = 2 * i + (lane >> 5); scr[kk * 33 + (lane & 31)] = W[(size_t)(k0 + kk) * ldw + col0 + n0 + (lane & 31)]; }
    LDS_WAIT(); asm volatile("" ::: "memory");
    const int c = lane & 7;
#pragma unroll
    for (int j = 0; j < 4; ++j) { const int n = (lane >> 3) + 8 * j; const LAS float* s = scr + (8 * c) * 33 + n;
        v4u o; o.x = pk2(s[0 * 33], s[1 * 33]); o.y = pk2(s[2 * 33], s[3 * 33]); o.z = pk2(s[4 * 33], s[5 * 33]); o.w = pk2(s[6 * 33], s[7 * 33]);
        *(GAS v4u*)(WT + (size_t)(row_off + map_row<MAP>(n0 + n)) * K + k0 + 8 * c) = o; }
    LDS_WAIT(); asm volatile("" ::: "memory");
}
template <int MAP> __device__ __forceinline__ void tr_item_f8(const float* W, int ldw, int K, int nblk, unsigned char* WT, float scale, LAS float* scr, int item, int lane) {
    const int kb = item / nblk, nb = item % nblk, k0 = 64 * kb, n0 = 32 * nb;
#pragma unroll 8
    for (int i = 0; i < 32; ++i) { const int kk = 2 * i + (lane >> 5); scr[kk * 33 + (lane & 31)] = W[(size_t)(k0 + kk) * ldw + n0 + (lane & 31)]; }
    LDS_WAIT(); asm volatile("" ::: "memory");
#pragma unroll
    for (int j = 0; j < 2; ++j) { const int idx = lane + 64 * j, n = idx & 31, c = idx >> 5; const LAS float* s = scr + (16 * c) * 33 + n; float v[16];
#pragma unroll
        for (int i = 0; i < 16; ++i) v[i] = s[i * 33] * scale;
        v4u o; o.x = pk4_fp8(v[0], v[1], v[2], v[3]); o.y = pk4_fp8(v[4], v[5], v[6], v[7]); o.z = pk4_fp8(v[8], v[9], v[10], v[11]); o.w = pk4_fp8(v[12], v[13], v[14], v[15]);
        *(GAS v4u*)(WT + (size_t)map_row<MAP>(n0 + n) * K + k0 + 16 * c) = o; }
    LDS_WAIT(); asm volatile("" ::: "memory");
}
struct TrJob { const float* W; unsigned char* WT; int ldw, K, k0, n0, map, f8, row_off; float scale; };
__device__ __forceinline__ int map_row_rt(int map, int n) { return map == 0 ? n : (((n >> 7) << 8) + (map == 2 ? 128 : 0) + (n & 127)); }
__device__ __forceinline__ bool tr_get_job(Frame& F, int it, TrJob& j) {
    const float* const* in = F.in;
    constexpr int IU = 16 * 16, I1 = 16 * 48, I2 = 16 * 32, I3 = 16 * 88, I5 = 44 * 32, I6 = 16 * 36, I7 = 16 * 8, I9 = 4 * 8, IE1 = 16 * 112, IE2 = 56 * 32;
    constexpr int T0 = IU, T1 = T0 + I1, T2 = T1 + I2, T3 = T2 + I3, T4 = T3 + I3, T5 = T4 + I5, T6 = T5 + I6, T7 = T6 + I7, T8 = T7 + I2, T9 = T8 + I9, T10 = T9 + 8 * IE1, T11 = T10 + 8 * IE1, T12 = T11 + 8 * IE2;
    if (it >= T12) return false;
    int nblk, item, col0 = 0; j.map = 0; j.f8 = 0; j.row_off = 0; j.scale = 1.0f;
    if (it < T0)       { j.W = in[8];  j.ldw = 2048; j.K = 1024; nblk = 16; j.WT = F.ws + WS_WFT;   item = it; }
    else if (it < T1)  { j.W = in[8];  j.ldw = 2048; j.K = 1024; nblk = 48; j.WT = F.ws + WS_WQKVE; item = it - T0; col0 = 512; j.f8 = 1; j.scale = 32.0f; }
    else if (it < T2)  { j.W = in[12]; j.ldw = 1024; j.K = 1024; nblk = 32; j.WT = F.ws + WS_WOE;   item = it - T1; }
    else if (it < T3)  { j.W = in[13]; j.ldw = DFF;  j.K = 1024; nblk = 88; j.WT = F.ws + WS_W13E;  item = it - T2; j.map = 1; j.f8 = 1; j.scale = 32.0f; }
    else if (it < T4)  { j.W = in[14]; j.ldw = DFF;  j.K = 1024; nblk = 88; j.WT = F.ws + WS_W13E;  item = it - T3; j.map = 2; j.f8 = 1; j.scale = 32.0f; }
    else if (it < T5)  { j.W = in[15]; j.ldw = 1024; j.K = DFF;  nblk = 32; j.WT = F.ws + WS_W2E;   item = it - T4; }
    else if (it < T6)  { j.W = in[20]; j.ldw = 1408; j.K = 1024; nblk = 36; j.WT = F.ws + WS_WINO;  item = it - T5; j.f8 = 1; j.scale = 32.0f; }
    else if (it < T7)  { j.W = in[20]; j.ldw = 1408; j.K = 1024; nblk = 8;  j.WT = F.ws + WS_WINO;  item = it - T6; col0 = 1152; j.row_off = 1280; j.f8 = 1; j.scale = 32.0f; }
    else if (it < T8)  { j.W = in[33]; j.ldw = 1024; j.K = 1024; nblk = 32; j.WT = F.ws + WS_WOO;   item = it - T7; }
    else if (it < T9)  { j.W = in[31]; j.ldw = 256;  j.K = 256;  nblk = 8;  j.WT = F.ws + WS_GLUW;  item = it - T8; }
    else if (it < T10) { const int r = it - T9, e = r / IE1;  j.W = in[36] + (size_t)e * 1024 * DFE; j.ldw = DFE;  j.K = 1024; nblk = 112; j.WT = F.ws + WS_EW13 + (size_t)e * 7168 * 1024; item = r % IE1; j.map = 1; j.f8 = 1; j.scale = 32.0f; }
    else if (it < T11) { const int r = it - T10, e = r / IE1; j.W = in[37] + (size_t)e * 1024 * DFE; j.ldw = DFE;  j.K = 1024; nblk = 112; j.WT = F.ws + WS_EW13 + (size_t)e * 7168 * 1024; item = r % IE1; j.map = 2; j.f8 = 1; j.scale = 32.0f; }
    else               { const int r = it - T11, e = r / IE2; j.W = in[38] + (size_t)e * DFE * 1024; j.ldw = 1024; j.K = DFE;  nblk = 32;  j.WT = F.ws + WS_EW2 + (size_t)e * 1024 * DFE;   item = r % IE2; j.f8 = 1; j.scale = 64.0f; }
    j.k0 = 64 * (item / nblk); j.n0 = 32 * (item % nblk); j.W += col0;
    return true;
}
__device__ __forceinline__ void tr_load(const TrJob& j, int lane, f32x4 (&r)[8]) {
#pragma unroll
    for (int i = 0; i < 8; ++i) r[i] = *(const f32x4*)(j.W + (size_t)(j.k0 + 8 * i + (lane >> 3)) * j.ldw + j.n0 + (lane & 7) * 4);
}
__device__ __forceinline__ void tr_to_lds(LAS float* scr, int lane, const f32x4 (&r)[8]) {
#pragma unroll
    for (int i = 0; i < 8; ++i) { LAS float* d = scr + (8 * i + (lane >> 3)) * 33 + (lane & 7) * 4; d[0] = r[i].x; d[1] = r[i].y; d[2] = r[i].z; d[3] = r[i].w; }
}
__device__ __forceinline__ void tr_finish(const TrJob& j, LAS float* scr, int lane) {
    if (j.f8) {
#pragma unroll
        for (int q = 0; q < 2; ++q) { const int idx = lane + 64 * q, n = idx & 31, c = idx >> 5; const LAS float* s = scr + (16 * c) * 33 + n; float v[16];
#pragma unroll
            for (int i = 0; i < 16; ++i) v[i] = s[i * 33] * j.scale;
            v4u o; o.x = pk4_fp8(v[0], v[1], v[2], v[3]); o.y = pk4_fp8(v[4], v[5], v[6], v[7]); o.z = pk4_fp8(v[8], v[9], v[10], v[11]); o.w = pk4_fp8(v[12], v[13], v[14], v[15]);
            *(GAS v4u*)(j.WT + (size_t)(j.row_off + map_row_rt(j.map, j.n0 + n)) * j.K + j.k0 + 16 * c) = o; }
    } else { const int c = lane & 7;
#pragma unroll
        for (int q = 0; q < 4; ++q) { const int n = (lane >> 3) + 8 * q; const LAS float* s = scr + (8 * c) * 33 + n;
            v4u o; o.x = pk2(s[0 * 33], s[1 * 33]); o.y = pk2(s[2 * 33], s[3 * 33]); o.z = pk2(s[4 * 33], s[5 * 33]); o.w = pk2(s[6 * 33], s[7 * 33]);
            *(GAS v4u*)((bf16*)j.WT + (size_t)(j.row_off + map_row_rt(j.map, j.n0 + n)) * j.K + j.k0 + 8 * c) = o; }
    }
}
__device__ __forceinline__ void prologue_wave_items(Frame& F) {
    LAS float* scr = (LAS float*)(F.lds + RING_OFF + F.wave * 16384);
    const int gw = F.vcu * NWAVES + F.wave, NGW = F.G * NWAVES, lane = F.lane;
    { TrJob cur, nxt; f32x4 r[8]; int it = gw; bool have = tr_get_job(F, it, cur); if (have) tr_load(cur, lane, r);
      while (have) { tr_to_lds(scr, lane, r); it += NGW; const bool hn = tr_get_job(F, it, nxt); if (hn) tr_load(nxt, lane, r);
          LDS_WAIT(); asm volatile("" ::: "memory"); tr_finish(cur, scr, lane); LDS_WAIT(); asm volatile("" ::: "memory"); cur = nxt; have = hn; } }
    const int gt = gw * 64 + lane, NGT = NGW * 64;
    { v4u z = {0u, 0u, 0u, 0u}; v4u* p = (v4u*)(wsp<unsigned char>(F, WS_WINO) + (size_t)1152 * 1024); for (int i = gt; i < 128 * 1024 / 16; i += NGT) p[i] = z; }
    { bf16* T = wsp<bf16>(F, WS_D256L);
      for (int idx = gt; idx < 512 * 64; idx += NGT) { const int row = idx >> 6, col = (idx & 63) * 8, rip = row >> 8, k2 = row & 255, ri = col >> 8, n0 = col & 255; float v[8];
#pragma unroll
          for (int e = 0; e < 8; ++e) { const int j = (k2 * (n0 + e)) & 255; float s, c; sincospif((float)j * (1.0f / 128.0f), &s, &c); v[e] = (rip == ri ? c : (rip ? -s : s)) * (1.0f / 512.0f); }
          v4u o; o.x = pk2(v[0], v[1]); o.y = pk2(v[2], v[3]); o.z = pk2(v[4], v[5]); o.w = pk2(v[6], v[7]); *(v4u*)(T + (size_t)row * 512 + col) = o; } }
    { bf16* T = wsp<bf16>(F, WS_D256C);
      for (int idx = gt; idx < 512 * 32; idx += NGT) { const int row = idx >> 5, col = (idx & 31) * 8, rip = row >> 8, k = row & 255; float v[8];
#pragma unroll
          for (int e = 0; e < 8; ++e) { const int j = (k * (col + e)) & 255; float s, c; sincospif((float)j * (1.0f / 128.0f), &s, &c); v[e] = (rip ? -s : c) * 0.005524271728019903f; }
          v4u o; o.x = pk2(v[0], v[1]); o.y = pk2(v[2], v[3]); o.z = pk2(v[4], v[5]); o.w = pk2(v[6], v[7]); *(v4u*)(T + (size_t)row * 256 + col) = o; } }
    { bf16* T = wsp<bf16>(F, WS_FC);
      for (int idx = gt; idx < 256 * 64; idx += NGT) { const int row = idx >> 6, col = (idx & 63) * 8, gl = row >> 7, cp = row & 127, gl2 = col >> 8, ri = (col >> 7) & 1, c0 = col & 127; float v[8];
#pragma unroll
          for (int e = 0; e < 8; ++e) { const int j = (cp * (c0 + e)) & 127; float s, c; sincospif((float)j * (1.0f / 64.0f), &s, &c); v[e] = (gl == gl2) ? (ri ? s : c) : 0.f; }
          v4u o; o.x = pk2(v[0], v[1]); o.y = pk2(v[2], v[3]); o.z = pk2(v[4], v[5]); o.w = pk2(v[6], v[7]); *(v4u*)(T + (size_t)row * 512 + col) = o; } }
    { f32x2* T = wsp<f32x2>(F, WS_TWD);
      for (int idx = gt; idx < 5 * 256; idx += NGT) { const int k1 = idx >> 8, n2 = idx & 255; float s, c; sincospif((float)(k1 * n2) * (1.0f / 1024.0f), &s, &c); T[idx] = (f32x2){c, s}; } }
    { float* T = wsp<float>(F, WS_BTG); const float* rpb = F.in[11];
      for (int idx = gt; idx < 8 * 17 * 128 * 32; idx += NGT) { const int e4 = idx & 3, ls = (idx >> 2) & 127, j = (idx >> 9) & 7, kind = (idx >> 12) % 17, h = idx / (17 * 4096);
          const int e = 4 * j + e4, qc = (ls >> 6) * 32 + (ls & 31), hi_ = (ls >> 5) & 1, r = e & 15, kc = (r & 3) + 8 * (r >> 2) + 4 * hi_ + 32 * (e >> 4); int cs = qc - 8; cs = cs < 0 ? 0 : (cs > 48 ? 48 : cs);
          float v = -INFINITY; if (kind == 15) v = 0.f; else if (kind < 15 && kc >= cs && kc <= cs + 15) v = rpb[h * 465 + kind * 31 + (kc - qc + 15)] * LOG2E;
          T[idx] = v; } }
    { float* rc = wsp<float>(F, WS_ROPE); float* rs = rc + 2048 * 32;
      for (int idx = gt; idx < 2048 * 32; idx += NGT) { const int n = idx >> 5, i = idx & 31; const float pos = (float)((i < 16) ? (n >> 6) : (n & 63));
          const float fr = exp2f(-(float)(i & 15) * (13.287712379549449f / 16.0f)); float s, c; sincosf(pos * fr, &s, &c); rc[idx] = c; rs[idx] = s; } }
}
__device__ __forceinline__ void prologue_mod_item(Frame& F, int item) {
    const int layer = item / 96, cb = item % 96, w = F.wave, lane = F.lane; const int col = cb * 64 + lane;
    const float* mw = F.in[layer ? 16 : 4]; const float* mb = F.in[layer ? 17 : 5]; const float* cnd = F.in[1]; const float* cctx = F.in[3];
    LAS float* sl = (LAS float*)(F.lds + RING_OFF) + w * (64 * 36);
    float acc[33];
#pragma unroll
    for (int r = 0; r < 33; ++r) acc[r] = 0.f;
    for (int half = 0; half < 2; ++half) { const int kb = 128 * w + 64 * half;
#pragma unroll 3
        for (int r = 0; r < 33; ++r) { const float v = (r < 32) ? cnd[r * 1024 + kb + lane] : cctx[kb + lane]; sl[lane * 36 + r] = v / (1.0f + expf(-v)); }
        LDS_WAIT(); asm volatile("" ::: "memory");
#pragma unroll 1
        for (int kk0 = 0; kk0 < 64; kk0 += 16) { float wv16[16];
#pragma unroll
            for (int x = 0; x < 16; ++x) wv16[x] = mw[(size_t)(kb + kk0 + x) * 6144 + col];
#pragma unroll
            for (int x = 0; x < 16; ++x) { const int kk = kk0 + x; const float wv = wv16[x]; const LAS f32x4* sp = (const LAS f32x4*)(sl + kk * 36);
#pragma unroll
                for (int q = 0; q < 8; ++q) { const f32x4 s4 = sp[q]; acc[4 * q] += s4.x * wv; acc[4 * q + 1] += s4.y * wv; acc[4 * q + 2] += s4.z * wv; acc[4 * q + 3] += s4.w * wv; }
                acc[32] += sl[kk * 36 + 32] * wv; } }
        LDS_WAIT(); asm volatile("" ::: "memory"); }
    __syncthreads();
    LAS float* red = (LAS float*)(F.lds + RING_OFF);
#pragma unroll
    for (int r = 0; r < 33; ++r) red[(w * 33 + r) * 64 + lane] = acc[r];
    __syncthreads();
    float* MODp = wsp<float>(F, WS_MOD);
    for (int o = F.tid; o < 33 * 64; o += 512) { const int r = o >> 6, l = o & 63; float s = 0.f;
#pragma unroll
        for (int ww = 0; ww < 8; ++ww) s += red[(ww * 33 + r) * 64 + l];
        MODp[(size_t)(layer * 33 + r) * 6144 + cb * 64 + l] = s + mb[cb * 64 + l]; }
    __syncthreads();
}
__device__ __forceinline__ void prologue_s5_item(Frame& F, int g) {
    LAS f32x2* lbt = (LAS f32x2*)(F.lds + RING_OFF);
    LAS f32x2* bfc = lbt + 2 * 17 * 64;
    LAS f32x2* Bm = bfc + 128;
    LAS f32x2* Cm = Bm + 2048;
    LAS float* Kt = (LAS float*)(Cm + 2048);
    const int tid = F.tid; const float* const* in = F.in;
    if (tid < 128) { const int dir = tid >> 6, p = tid & 63, gi = (dir * 16 + g) * 64 + p; const float are = in[23][gi], aim = in[24][gi], stp = expf(in[25][dir * 16 + g]);
        for (int t = 0; t <= 16; ++t) { const float mag = expf((float)t * stp * are); float s, c; sincosf((float)t * stp * aim, &s, &c); lbt[(dir * 17 + t) * 64 + p] = (f32x2){mag * c, mag * s}; }
        const f32x2 l1 = lbt[(dir * 17 + 1) * 64 + p]; const float x = l1.x - 1.0f, y = l1.y, den = 1.0f / (are * are + aim * aim);
        bfc[dir * 64 + p] = (f32x2){(x * are + y * aim) * den, (y * are - x * aim) * den};
        wsp<f32x2>(F, WS_L16)[(g * 2 + dir) * 64 + p] = lbt[(dir * 17 + 16) * 64 + p]; }
    __syncthreads();
    for (int i = tid; i < 2048; i += 512) { const int dir = i >> 10, p = (i >> 4) & 63, n = i & 15; const size_t gi = ((size_t)(dir * 16 + g) * 64 + p) * 16 + n;
        const float br = in[26][gi], bi = in[27][gi]; const f32x2 f = bfc[dir * 64 + p]; Bm[i] = (f32x2){f.x * br - f.y * bi, f.x * bi + f.y * br}; }
    for (int i = tid; i < 2048; i += 512) { const int dir = i >> 10, m = (i >> 6) & 15, p = i & 63; const size_t gi = ((size_t)(dir * 16 + g) * 16 + m) * 64 + p; Cm[i] = (f32x2){in[28][gi], in[29][gi]}; }
    __syncthreads();
    for (int i = tid; i < 8192; i += 512) { const int dir = i >> 12, t = (i >> 8) & 15, m = (i >> 4) & 15, n = i & 15; float s = 0.f;
        for (int p = 0; p < 64; ++p) { const f32x2 c = Cm[(dir * 16 + m) * 64 + p], l = lbt[(dir * 17 + t) * 64 + p], b = Bm[(dir * 64 + p) * 16 + n];
            const float wr_ = c.x * l.x - c.y * l.y, wi_ = c.x * l.y + c.y * l.x; s += wr_ * b.x - wi_ * b.y; }
        Kt[i] = s; }
    __syncthreads();
    bf16* PST = wsp<bf16>(F, WS_PST) + (size_t)g * 65536; bf16* MQT = wsp<bf16>(F, WS_MQT) + (size_t)g * 131072;
    for (int ch = tid; ch < 8192; ch += 512) { const int q = ch >> 5, kk0 = (ch & 31) * 8, dir = q >> 7, ri = (q >> 6) & 1, p = q & 63, j = kk0 >> 4, n0 = kk0 & 15; const int e = dir ? j : 15 - j;
        const f32x2 l = lbt[(dir * 17 + e) * 64 + p]; float v[8];
#pragma unroll
        for (int x = 0; x < 8; ++x) { const f32x2 b = Bm[(dir * 64 + p) * 16 + n0 + x]; v[x] = ri ? (l.x * b.y + l.y * b.x) : (l.x * b.x - l.y * b.y); }
        v4u o; o.x = pk2(v[0], v[1]); o.y = pk2(v[2], v[3]); o.z = pk2(v[4], v[5]); o.w = pk2(v[6], v[7]); *(v4u*)(PST + (size_t)q * 256 + kk0) = o; }
    for (int ch = tid; ch < 16384; ch += 512) { const int row = ch >> 6, c0 = (ch & 63) * 8, i = row >> 4, m = row & 15; float v[8];
        if (c0 < 256) { const int j = c0 >> 4, n0 = c0 & 15;
#pragma unroll
            for (int x = 0; x < 8; ++x) { float s = 0.f; if (j <= i) s += Kt[((0 * 16 + (i - j)) * 16 + m) * 16 + n0 + x]; if (j >= i) s += Kt[((1 * 16 + (j - i)) * 16 + m) * 16 + n0 + x]; v[x] = s; } }
        else { const int cc = c0 - 256, dir = cc >> 7, ri = (cc >> 6) & 1, p0 = cc & 63; const int e = dir ? 16 - i : i + 1;
#pragma unroll
            for (int x = 0; x < 8; ++x) { const f32x2 c = Cm[(dir * 16 + m) * 64 + p0 + x], l = lbt[(dir * 17 + e) * 64 + p0 + x]; v[x] = ri ? -(c.x * l.y + c.y * l.x) : (c.x * l.x - c.y * l.y); } }
        v4u o; o.x = pk2(v[0], v[1]); o.y = pk2(v[2], v[3]); o.z = pk2(v[4], v[5]); o.w = pk2(v[6], v[7]); *(v4u*)(MQT + (size_t)row * 512 + c0) = o; }
    __syncthreads();
}

__device__ __forceinline__ void norm_row(const float* xrow, const float* gain, const float* shift, const float* scale, int lane, f32x4 (&h)[4]) {
    const f32x4* xr = (const f32x4*)xrow + lane; float ss = 0.f;
#pragma unroll
    for (int j = 0; j < 4; ++j) { h[j] = xr[64 * j]; ss += (h[j].x * h[j].x + h[j].y * h[j].y) + (h[j].z * h[j].z + h[j].w * h[j].w); }
    const float rstd = 1.0f / sqrtf(wave_sum(ss) * (1.0f / 1024.0f) + EPSN);
#pragma unroll
    for (int j = 0; j < 4; ++j) { const f32x4 g = ((const f32x4*)gain)[lane + 64 * j], sh = ((const f32x4*)shift)[lane + 64 * j], sc = ((const f32x4*)scale)[lane + 64 * j];
        h[j] = (h[j] * rstd * g) * (sc + 1.0f) + sh; }
}
__device__ __forceinline__ void store_row_bf16(bf16* orow, int lane, const f32x4 (&h)[4]) {
    unsigned long long* o8 = (unsigned long long*)orow + lane;
#pragma unroll
    for (int j = 0; j < 4; ++j) o8[64 * j] = (unsigned long long)pk2(h[j].x, h[j].y) | ((unsigned long long)pk2(h[j].z, h[j].w) << 32);
}
template <int F8OUT = 0, bool XB16 = false> __device__ __forceinline__ void norm_phase(Frame& F, const void* xl, const void* xc, const float* gain, int layer, int chunk0) {
    const int gw = F.vcu * NWAVES + F.wave, NGW = F.G * NWAVES, lane = F.lane; bf16* HN = wsp<bf16>(F, WS_HN);
    constexpr int NR = 4;
    for (int m0 = gw * NR; m0 < M; m0 += NGW * NR) { const int b = m0 / TPB, t = m0 % TPB;
        const int bi = (t < CTXL) ? 32 : b; f32x4 h[NR][4]; float ss[NR];
        if (XB16) { const bf16* xrow = (t < CTXL) ? (const bf16*)xc + (size_t)(b * CTXL + t) * D : (const bf16*)xl + (size_t)(b * SEQ + t - CTXL) * D;
#pragma unroll
            for (int r = 0; r < NR; ++r) { const v2u* xr = (const v2u*)(xrow + (size_t)r * D) + lane;
#pragma unroll
                for (int j = 0; j < 4; ++j) h[r][j] = bf4_to_f32(xr[64 * j]); } }
        else { const float* xrow = (t < CTXL) ? (const float*)xc + (size_t)(b * CTXL + t) * D : (const float*)xl + (size_t)(b * SEQ + t - CTXL) * D;
#pragma unroll
            for (int r = 0; r < NR; ++r) { const f32x4* xr = (const f32x4*)(xrow + (size_t)r * D) + lane;
#pragma unroll
                for (int j = 0; j < 4; ++j) h[r][j] = xr[64 * j]; } }
        const float* shift = modp(F, layer, bi, chunk0); const float* scale = modp(F, layer, bi, chunk0 + 1);
        f32x4 g4[4], sh4[4], sc4[4];
#pragma unroll
        for (int j = 0; j < 4; ++j) { g4[j] = ((const f32x4*)gain)[lane + 64 * j]; sh4[j] = ((const f32x4*)shift)[lane + 64 * j]; sc4[j] = ((const f32x4*)scale)[lane + 64 * j]; g4[j] = g4[j] * (sc4[j] + 1.0f); }
#pragma unroll
        for (int r = 0; r < NR; ++r) { float s = 0.f;
#pragma unroll
            for (int j = 0; j < 4; ++j) s += (h[r][j].x * h[r][j].x + h[r][j].y * h[r][j].y) + (h[r][j].z * h[r][j].z + h[r][j].w * h[r][j].w);
            ss[r] = s; }
#pragma unroll
        for (int o = 1; o < 64; o <<= 1) {
#pragma unroll
            for (int r = 0; r < NR; ++r) ss[r] += __shfl_xor(ss[r], o); }
#pragma unroll
        for (int r = 0; r < NR; ++r) { const float rstd = 1.0f / sqrtf(ss[r] * (1.0f / 1024.0f) + EPSN);
#pragma unroll
            for (int j = 0; j < 4; ++j) h[r][j] = (h[r][j] * rstd) * g4[j] + sh4[j];
            if (F8OUT) { unsigned* H8 = (F8OUT == 2) ? wsp<unsigned>(F, WS_TT) : (unsigned*)HN;
#pragma unroll
                for (int j = 0; j < 4; ++j) H8[(size_t)(m0 + r) * 256 + lane + 64 * j] = pk4_fp8(h[r][j].x, h[r][j].y, h[r][j].z, h[r][j].w); }
            if (F8OUT != 1) store_row_bf16(HN + (size_t)(m0 + r) * D, lane, h[r]); } }
}
template <bool ODD> __device__ __forceinline__ void qkprep_phase(Frame& F) {
    const int gw = F.vcu * NWAVES + F.wave, NGW = F.G * NWAVES, lane = F.lane;
    bf16* H1 = wsp<bf16>(F, WS_H1); const int P = ODD ? H1O_P : H1E_P;
    const float* qg = F.in[ODD ? 21 : 9]; const float* kg = F.in[ODD ? 22 : 10];
    const float* rc = wsp<const float>(F, WS_ROPE); const float* rs = rc + 2048 * 32;
    const int d0 = (lane & 7) * 8;
    float gq[8], gk[8];
#pragma unroll
    for (int e = 0; e < 8; ++e) { gq[e] = qg[d0 + e] * C2; gk[e] = kg[d0 + e]; }
    for (int m0 = gw * 4; m0 < M; m0 += NGW * 4) { v4u wv[4][2];
#pragma unroll
      for (int r = 0; r < 4; ++r)
#pragma unroll
        for (int ch = 0; ch < 2; ++ch) { const int col = ch * 512 + lane * 8; if (!ODD || col < 960) wv[r][ch] = *(const v4u*)(H1 + (size_t)(m0 + r) * P + col); }
#pragma unroll
      for (int r = 0; r < 4; ++r) { const int m = m0 + r; const int t = m % TPB; bf16* row = H1 + (size_t)m * P;
#pragma unroll
        for (int ch = 0; ch < 2; ++ch) { const int col = ch * 512 + lane * 8;
            const bool isq = ODD ? (col < 768) : (ch == 0); const bool act = ODD ? (col < 960) : true;
            if (act) { const v4u w = wv[r][ch]; float v[8];
                v[0] = bflo(w.x); v[1] = bfhi(w.x); v[2] = bflo(w.y); v[3] = bfhi(w.y); v[4] = bflo(w.z); v[5] = bfhi(w.z); v[6] = bflo(w.w); v[7] = bfhi(w.w);
                float ss = 0.f;
#pragma unroll
                for (int e = 0; e < 8; ++e) ss += v[e] * v[e];
                ss += __shfl_xor(ss, 1); ss += __shfl_xor(ss, 2); ss += __shfl_xor(ss, 4);
                const float rstd = 1.0f / sqrtf(ss * (1.0f / 64.0f) + EPSN);
#pragma unroll
                for (int e = 0; e < 8; ++e) v[e] = v[e] * rstd * (isq ? gq[e] : gk[e]);
                if (ODD && t >= CTXL) { const int n = t - CTXL; const f32x4 c4 = *(const f32x4*)(rc + n * 32 + (lane & 7) * 4), s4 = *(const f32x4*)(rs + n * 32 + (lane & 7) * 4);
#pragma unroll
                    for (int pr = 0; pr < 4; ++pr) { const float x1 = v[2 * pr], x2 = v[2 * pr + 1]; v[2 * pr] = x1 * c4[pr] - x2 * s4[pr]; v[2 * pr + 1] = x1 * s4[pr] + x2 * c4[pr]; } }
                v4u o; o.x = pk2(v[0], v[1]); o.y = pk2(v[2], v[3]); o.z = pk2(v[4], v[5]); o.w = pk2(v[6], v[7]); *(v4u*)(row + col) = o; } } } }
}
__device__ __forceinline__ void dft8_phase(Frame& F) {
    const bf16* UTL = wsp<const bf16>(F, WS_UTL); bf16* TT = wsp<bf16>(F, WS_TT); const f32x2* TWD = wsp<const f32x2>(F, WS_TWD);
    const int gt = (F.vcu * NWAVES + F.wave) * 64 + F.lane, NGT = F.G * NWAVES * 64; const float r = 0.70710678118654752f;
    for (int idx = gt; idx < NB * 512 * 32; idx += NGT) { const int n20 = (idx & 31) * 8, bc = idx >> 5;
        const bf16* src_ = UTL + (size_t)bc * 2048 + n20; v4u in[8];
#pragma unroll
        for (int n1 = 0; n1 < 8; ++n1) in[n1] = *(const v4u*)(src_ + 256 * n1);
        float ore[5][8], oim[5][8];
#pragma unroll
        for (int e = 0; e < 8; ++e) { float a[8];
#pragma unroll
            for (int n1 = 0; n1 < 8; ++n1) { const unsigned w = (e >> 1) == 0 ? in[n1].x : ((e >> 1) == 1 ? in[n1].y : ((e >> 1) == 2 ? in[n1].z : in[n1].w)); a[n1] = (e & 1) ? bfhi(w) : bflo(w); }
            const float d0 = a[0] - a[4], d1 = a[1] - a[5], d2 = a[2] - a[6], d3 = a[3] - a[7], s0 = a[0] + a[4], s1 = a[1] + a[5], s2 = a[2] + a[6], s3 = a[3] + a[7];
            float tre[5], tim[5];
            tre[0] = (s0 + s2) + (s1 + s3); tim[0] = 0.f;
            tre[4] = (s0 + s2) - (s1 + s3); tim[4] = 0.f;
            tre[1] = d0 + r * (d1 - d3); tim[1] = -d2 - r * (d1 + d3);
            tre[2] = s0 - s2; tim[2] = s3 - s1;
            tre[3] = d0 - r * (d1 - d3); tim[3] = d2 - r * (d1 + d3);
            ore[0][e] = tre[0]; oim[0][e] = 0.f;
#pragma unroll
            for (int k1 = 1; k1 < 5; ++k1) { const f32x2 cs = TWD[k1 * 256 + n20 + e]; ore[k1][e] = tre[k1] * cs.x + tim[k1] * cs.y; oim[k1][e] = tim[k1] * cs.x - tre[k1] * cs.y; } }
        const int b = bc >> 9, c = bc & 511;
#pragma unroll
        for (int k1 = 0; k1 < 5; ++k1) { bf16* dst = TT + ((size_t)(b * 5 + k1) * 512 + c) * 512 + n20;
            v4u o; o.x = pk2(ore[k1][0], ore[k1][1]); o.y = pk2(ore[k1][2], ore[k1][3]); o.z = pk2(ore[k1][4], ore[k1][5]); o.w = pk2(ore[k1][6], ore[k1][7]); *(v4u*)dst = o;
            o.x = pk2(oim[k1][0], oim[k1][1]); o.y = pk2(oim[k1][2], oim[k1][3]); o.z = pk2(oim[k1][4], oim[k1][5]); o.w = pk2(oim[k1][6], oim[k1][7]); *(v4u*)(dst + 256) = o; } }
}
__device__ __forceinline__ void s5_scan_phase(Frame& F) {
    const int v0 = (F.G >= 256) ? F.vcu - (F.G - 128) : F.vcu; if (v0 < 0) return;
    const int id = v0 * 512 + F.tid; if (id >= 65536) return;
    const int p = id & 63, dir = (id >> 6) & 1, b = (id >> 7) & 31, g = id >> 12;
    const f32x2 l16 = wsp<const f32x2>(F, WS_L16)[(g * 2 + dir) * 64 + p];
    const unsigned short* S = wsp<const unsigned short>(F, WS_S) + ((size_t)g * 4608 + b * 144) * 256 + dir * 128 + p;
    bf16* X = wsp<bf16>(F, WS_AB) + ((size_t)g * 4608 + b * 144) * 512 + 256 + dir * 128 + p;
    float xr = 0.f, xi = 0.f;
    for (int k0 = 0; k0 < 144; k0 += 8) {
        float sr[8], si[8];
#pragma unroll
        for (int q = 0; q < 8; ++q) { const int k = k0 + q; const int c = (dir == 0) ? k : ((k < 16) ? 15 - k : 159 - k); sr[q] = __uint_as_float((unsigned)S[(size_t)c * 256] << 16); si[q] = __uint_as_float((unsigned)S[(size_t)c * 256 + 64] << 16); }
#pragma unroll
        for (int q = 0; q < 8; ++q) { const int k = k0 + q; const int c = (dir == 0) ? k : ((k < 16) ? 15 - k : 159 - k);
            X[(size_t)c * 512] = (bf16)f2bf(xr); X[(size_t)c * 512 + 64] = (bf16)f2bf(xi);
            const float nr = l16.x * xr - l16.y * xi + sr[q], ni = l16.x * xi + l16.y * xr + si[q]; xr = nr; xi = ni; } }
}
__device__ __forceinline__ void router_phase(Frame& F) {
    LAS int* lcnt = (LAS int*)(F.lds + RING_OFF);
    LAS int* lbase = lcnt + 16;
    LAS int* lte = lcnt + 32; LAS int* ltr = lte + 512; LAS float* ltw = (LAS float*)(ltr + 512);
    const int tid = F.tid, lane = F.lane, w = F.wave;
    int* stok = wsp<int>(F, WS_STOK);
    for (int i = F.vcu * 512 + tid; i < MAXSLOT; i += F.G * 512) stok[i] = -1;
    const float* rw = F.in[34]; const float* rb = F.in[35]; const float* gain = F.in[19];
    int* TKE = wsp<int>(F, WS_TKE); int* TKR = wsp<int>(F, WS_TKR); float* TKW = wsp<float>(F, WS_TKW); unsigned* HN8 = wsp<unsigned>(F, WS_HN);
    f32x4 rwr[16];
#pragma unroll
    for (int k = 0; k < 16; ++k) { const int jj = k >> 2, x = k & 3; rwr[k] = ((const f32x4*)(rw + (size_t)(4 * lane + 256 * jj + x) * 8))[0]; }
    LAS f32x4* rwL = (LAS f32x4*)(F.lds + RING_OFF + 8192);
    for (int i = tid; i < 16 * 64; i += 512) { const int l = i & 63, k = i >> 6, jj = k >> 2, x = k & 3; rwL[i] = ((const f32x4*)(rw + (size_t)(4 * l + 256 * jj + x) * 8))[1]; }
    LDS_WAIT(); __syncthreads();
#define RWV(k, half) ((half) ? rwL[(k) * 64 + lane] : rwr[(k)])
    float rbv[8];
#pragma unroll
    for (int e = 0; e < 8; ++e) rbv[e] = rb[e];
    const bool b5 = (lane & 32) != 0, b4 = (lane & 16) != 0, b3 = (lane & 8) != 0;
#define DOT8_REDUCE(v, out) do { float w_[4], u_[2]; \
        _Pragma("unroll") for (int i_ = 0; i_ < 4; ++i_) { const float snd = b5 ? v[i_] : v[4 + i_]; const float rcv = __shfl_xor(snd, 32); w_[i_] = (b5 ? v[4 + i_] : v[i_]) + rcv; } \
        _Pragma("unroll") for (int i_ = 0; i_ < 2; ++i_) { const float snd = b4 ? w_[i_] : w_[2 + i_]; const float rcv = __shfl_xor(snd, 16); u_[i_] = (b4 ? w_[2 + i_] : w_[i_]) + rcv; } \
        { const float snd = b3 ? u_[0] : u_[1]; const float rcv = __shfl_xor(snd, 8); out = (b3 ? u_[1] : u_[0]) + rcv; } \
        out += __shfl_xor(out, 4); out += __shfl_xor(out, 2); out += __shfl_xor(out, 1); } while (0)
    for (int blk = F.vcu; blk < MLAT / 256; blk += F.G) {
        if (tid < 16) lcnt[tid] = 0;
        __syncthreads();
        const int b = (blk * 256) >> 11;
        f32x4 g4[4]; const f32x4* shp = (const f32x4*)modp(F, 1, b, 3);
#pragma unroll
        for (int jj = 0; jj < 4; ++jj) g4[jj] = ((const f32x4*)gain)[lane + 64 * jj] * (((const f32x4*)modp(F, 1, b, 4))[lane + 64 * jj] + 1.0f);
        float c0[8];
        { float pv[8];
#pragma unroll
          for (int e = 0; e < 8; ++e) pv[e] = 0.f;
#pragma unroll
          for (int jj = 0; jj < 4; ++jj)
#pragma unroll
              for (int x = 0; x < 4; ++x) { const float hv = shp[lane + 64 * jj][x]; const f32x4 w0 = RWV(jj * 4 + x, 0), w1 = RWV(jj * 4 + x, 1);
                  pv[0] += hv * w0.x; pv[1] += hv * w0.y; pv[2] += hv * w0.z; pv[3] += hv * w0.w; pv[4] += hv * w1.x; pv[5] += hv * w1.y; pv[6] += hv * w1.z; pv[7] += hv * w1.w; }
          float t; DOT8_REDUCE(pv, t);
#pragma unroll
          for (int e = 0; e < 8; ++e) c0[e] = __shfl(t, 8 * e) + rbv[e]; }
        const int tok0 = blk * 256 + w * 32;
        f32x4 xn[4];
#pragma unroll
        for (int jj = 0; jj < 4; ++jj) xn[jj] = bf4_to_f32(((const v2u*)(F.XL + (size_t)tok0 * D))[lane + 64 * jj]);
        for (int j = 0; j < 32; ++j) { const int tok = tok0 + j; f32x4 y[4];
#pragma unroll
            for (int jj = 0; jj < 4; ++jj) y[jj] = xn[jj];
            if (j < 31) {
#pragma unroll
                for (int jj = 0; jj < 4; ++jj) xn[jj] = bf4_to_f32(((const v2u*)(F.XL + (size_t)(tok + 1) * D))[lane + 64 * jj]); }
            float ss = 0.f, pv[8];
#pragma unroll
            for (int e = 0; e < 8; ++e) pv[e] = 0.f;
#pragma unroll
            for (int jj = 0; jj < 4; ++jj) { ss += (y[jj].x * y[jj].x + y[jj].y * y[jj].y) + (y[jj].z * y[jj].z + y[jj].w * y[jj].w); y[jj] = y[jj] * g4[jj];
#pragma unroll
                for (int x = 0; x < 4; ++x) { const float hv = y[jj][x]; const f32x4 w0 = RWV(jj * 4 + x, 0), w1 = RWV(jj * 4 + x, 1);
                    pv[0] += hv * w0.x; pv[1] += hv * w0.y; pv[2] += hv * w0.z; pv[3] += hv * w0.w; pv[4] += hv * w1.x; pv[5] += hv * w1.y; pv[6] += hv * w1.z; pv[7] += hv * w1.w; } }
            float t; DOT8_REDUCE(pv, t);
            const float rstd = 1.0f / sqrtf(wave_sum(ss) * (1.0f / 1024.0f) + EPSN);
            float lg[8];
#pragma unroll
            for (int e = 0; e < 8; ++e) lg[e] = __shfl(t, 8 * e) * rstd + c0[e];
#pragma unroll
            for (int jj = 0; jj < 4; ++jj) { const f32x4 h = y[jj] * rstd + shp[lane + 64 * jj]; HN8[(size_t)tok * 256 + lane + 64 * jj] = pk4_fp8(h.x, h.y, h.z, h.w); }
            int e1 = 0; float v1 = lg[0];
#pragma unroll
            for (int e = 1; e < 8; ++e) if (lg[e] > v1) { v1 = lg[e]; e1 = e; }
            int e2 = -1; float v2 = -INFINITY;
#pragma unroll
            for (int e = 0; e < 8; ++e) if (e != e1 && lg[e] > v2) { v2 = lg[e]; e2 = e; }
            const float w2 = 1.0f / (1.0f + expf(v1 - v2)), w1 = 1.0f - w2;
            if (lane == 0) { const int r1 = __hip_atomic_fetch_add(lcnt + e1, 1, __ATOMIC_RELAXED, __HIP_MEMORY_SCOPE_WORKGROUP), r2 = __hip_atomic_fetch_add(lcnt + 8 + e2, 1, __ATOMIC_RELAXED, __HIP_MEMORY_SCOPE_WORKGROUP);
                const int lt = w * 32 + j; lte[lt * 2] = e1; lte[lt * 2 + 1] = e2; ltr[lt * 2] = r1; ltr[lt * 2 + 1] = r2; ltw[lt * 2] = w1; ltw[lt * 2 + 1] = w2; } }
        LDS_WAIT(); __syncthreads();
        if (tid < 16) lbase[tid] = (int)__hip_atomic_fetch_add(F.ctl + CW_MOE + 64 * tid, (unsigned)lcnt[tid], RLX_AGENT);
        __syncthreads();
        if (tid < 256) { const int tok = blk * 256 + tid; const int e1 = lte[tid * 2], e2 = lte[tid * 2 + 1];
            TKE[tok * 2] = e1; TKE[tok * 2 + 1] = e2; TKR[tok * 2] = ltr[tid * 2] + lbase[e1]; TKR[tok * 2 + 1] = ltr[tid * 2 + 1] + lbase[8 + e2]; TKW[tok * 2] = ltw[tid * 2]; TKW[tok * 2 + 1] = ltw[tid * 2 + 1]; }
        __syncthreads();
    }
#undef DOT8_REDUCE
#undef RWV
}
__device__ __forceinline__ int moe_layout(Frame& F, int (&ps)[17]) {
    int acc = 0;
#pragma unroll
    for (int j = 0; j < 16; ++j) { ps[j] = acc; const int c = (int)__builtin_amdgcn_readfirstlane(__hip_atomic_load(F.ctl + CW_MOE + 64 * j, RLX_AGENT)); acc += (c + 255) >> 8; }
    ps[16] = acc; return acc;
}
__device__ __forceinline__ void gather_phase(Frame& F) {
    int ps[17]; moe_layout(F, ps);
    if (blockIdx.x == 0) { const int tid = F.tid;
        for (int pnl = tid; pnl < ps[16]; pnl += 512) { int e = 0;
#pragma unroll
            for (int j = 1; j < 16; ++j) if (pnl >= ps[j]) e = j;
            __hip_atomic_store(F.ctl + CW_PEXP + pnl, (unsigned)(e & 7), RLX_AGENT); }
        if (tid == 0) { __hip_atomic_store(F.ctl + CW_CHUNK, (unsigned)ps[8], RLX_AGENT); __hip_atomic_store(F.ctl + CW_CHUNK + 1, (unsigned)ps[16], RLX_AGENT); } }
    const int gw = F.vcu * NWAVES + F.wave, NGW = F.G * NWAVES, lane = F.lane;
    const int* TKE = wsp<const int>(F, WS_TKE); const int* TKR = wsp<const int>(F, WS_TKR); const float* TKW = wsp<const float>(F, WS_TKW);
    int* stok = wsp<int>(F, WS_STOK); float* sw = wsp<float>(F, WS_SW); const v4u* HN8 = wsp<const v4u>(F, WS_HN); unsigned char* HNG = wsp<unsigned char>(F, WS_HNG);
    for (int tok0 = gw * 8; tok0 < MLAT; tok0 += NGW * 8) { v4u a0[8]; int ee[8][2], rr[8][2];
#pragma unroll
        for (int r = 0; r < 8; ++r) { const int tok = tok0 + r; a0[r] = HN8[(size_t)tok * 64 + lane];
            ee[r][0] = TKE[tok * 2]; ee[r][1] = TKE[tok * 2 + 1]; rr[r][0] = TKR[tok * 2]; rr[r][1] = TKR[tok * 2 + 1]; }
#pragma unroll
        for (int r = 0; r < 8; ++r) { const int tok = tok0 + r;
#pragma unroll
            for (int h = 0; h < 2; ++h) { int base = 0;
#pragma unroll
                for (int j = 0; j < 16; ++j) if (j == h * 8 + ee[r][h]) base = ps[j];
                const int slot = base * 256 + rr[r][h];
                *((v4u*)(HNG + (size_t)slot * D) + lane) = a0[r];
                if (lane == 0) { stok[slot] = tok; sw[slot] = TKW[tok * 2 + h]; } } } }
}

struct Args { const float* in[39]; float* out; unsigned char* ws; int ph_lo, ph_hi, li, pad; };
__global__ void __launch_bounds__(NWAVES * 64, 2) mk_fwd(Args args) {
    extern __shared__ __attribute__((aligned(16))) unsigned char lds[];
    Frame F;
    F.lds = (LAS unsigned char*)lds;
    F.MISC = (volatile LAS unsigned*)(F.lds + MISC_OFF);
    F.tid = threadIdx.x; F.lane = F.tid & 63; F.wave = __builtin_amdgcn_readfirstlane(F.tid >> 6);
    F.G = gridDim.x; { const int bx = blockIdx.x; F.vcu = (F.G % 8 == 0) ? (bx % 8) * (F.G / 8) + bx / 8 : bx; }
    F.in = args.in; F.ws = args.ws; F.ctl = (unsigned*)(args.ws + WS_CTL);
    F.XL = (bf16*)((char*)args.out + (size_t)128 * MiB); F.OUT = args.out; F.X3P = (bf16*)(args.ws + WS_HN); F.XC = (bf16*)(args.ws + WS_XC);
    for (int u = F.tid; u < (LDS_BYTES - LDSCTL_OFF) / 4; u += NWAVES * 64) ((LAS unsigned*)(F.lds + LDSCTL_OFF))[u] = 0u;
    __syncthreads();
    XcdBarrier bar; bar.bar = F.ctl + CW_BAR + (MK_PER_PHASE ? 0 : args.li) * XCD_BAR_WORDS; bar.x = 0; bar.st = nullptr;
    if (!MK_PER_PHASE) bar = xcd_barrier_post(F.ctl + CW_BAR + args.li * XCD_BAR_WORDS, F.MISC + 8);
#define GRID_BAR() do { if (MK_PER_PHASE) { if (F.tid == 0) __hip_atomic_store(F.ctl + CW_TMO, 0xBADBA0u, RLX_AGENT); } else { xcd_barrier(bar); } } while (0)
    const int lo = args.ph_lo, hi = args.ph_hi;
#ifndef PHMASK
#define PHMASK 0xFFFFFFFFu
#endif
#define IN(k) (((PHMASK >> (k)) & 1u) && lo <= (k) && (k) < hi)
#define FLAG_ARRIVE(j) do { asm volatile("s_waitcnt vmcnt(0)" ::: "memory"); __syncthreads(); if (F.tid == 0) { __builtin_amdgcn_fence(__ATOMIC_RELEASE, "agent"); asm volatile("s_waitcnt vmcnt(0)" ::: "memory"); (void)xb_add(F.ctl + CW_FLAG + 64 * (j), 1u); } } while (0)
#define FLAG_WAIT(j) do { if (F.tid == 0) { XB_SPIN(xb_ld(F.ctl + CW_FLAG + 64 * (j)) < (unsigned)F.G, bar.bar); __builtin_amdgcn_fence(__ATOMIC_ACQUIRE, "agent"); asm volatile("s_waitcnt vmcnt(0)" ::: "memory"); } __syncthreads(); } while (0)
#ifndef REPMASK
#define REPMASK 0u
#endif
#define REPS(k) for (int rep_ = 0; rep_ < (((REPMASK >> (k)) & 1u) ? 2 : 1); ++rep_)
#define SEAM(k) do { if (IN(k) && IN((k) + 1)) GRID_BAR(); } while (0)
    const int bx = (int)blockIdx.x;
    bf16* HN = wsp<bf16>(F, WS_HN); bf16* H1 = wsp<bf16>(F, WS_H1); bf16* OB = wsp<bf16>(F, WS_O); bf16* OBE = wsp<bf16>(F, WS_OE);
    const float* MOD0 = wsp<const float>(F, WS_MOD); const float* MOD1 = MOD0 + 33 * 6144;
    LAS unsigned char* ring = F.lds + RING_OFF;

    if (IN(0)) REPS(0) {
        for (int it = bx; it < 208; it += F.G) { if (it < 192) prologue_mod_item(F, it); else prologue_s5_item(F, it - 192); }
        prologue_wave_items(F);
        VM_WAIT(); __syncthreads();
    }
    SEAM(0);
    if (IN(1)) norm_phase<2>(F, F.in[0], F.in[2], F.in[6], 0, 0);
    SEAM(1);
    if (IN(2)) REPS(2) {
        { pg8::Gemm g{wsp<const bf16>(F, WS_WFT), HN, 1024, 1024, 1024}; pg8::Order S; S.init(2, NPAN, F.G, bx, pg8::OM_PLAIN, 2, (size_t)256 * 1024 * 2, (size_t)256 * 1024 * 2, 0, 0);
          EpiFourT E{wsp<bf16>(F, WS_UTL), wsp<bf16>(F, WS_UTC)}; pg8::gemm_phase<EpiFourT, pg8::Order, true>(ring, g, S, E); }
        { pg8::Gemm g{wsp<const bf16>(F, WS_TT), wsp<const bf16>(F, WS_WQKVE), 1024, 1024, 1024}; pg8::Order S; S.init(NPAN, 6, F.G, (bx + 192) % F.G, pg8::OM_PLAIN, NPAN, (size_t)256 * 1024, (size_t)256 * 1024, 0, 0);
          EpiQKV<false> E{H1, nullptr, F.in[9], F.in[10], nullptr, nullptr, (LAS float*)(F.lds + LDSCTL_OFF + 1024), 0.03125f, 0}; pg8::gemm_phase<EpiQKV<false>, pg8::Order, true, true>(ring, g, S, E); }
    }
    SEAM(2);
    if (IN(3)) { dft8_phase(F); }
    SEAM(3);
    if (IN(4)) REPS(4) {
        { pg8::Gemm g{wsp<const bf16>(F, WS_D256L), wsp<const bf16>(F, WS_TT), 512, 512, 512}; pg8::Order S; S.init(NB * 5 * 2, 2, F.G, bx, pg8::OM_ZB, 2, (size_t)256 * 512 * 2, (size_t)256 * 512 * 2, 0, (size_t)512 * 512 * 2);
          EpiVT E{wsp<bf16>(F, WS_VT), 1}; pg8::gemm_phase<EpiVT, pg8::Order, true>(ring, g, S, E); }
        { pg8::Gemm g{wsp<const bf16>(F, WS_D256C), wsp<const bf16>(F, WS_UTC), 256, 256, 256}; pg8::Order S; S.init(NB * 2, 2, F.G, (bx + 128) % F.G, pg8::OM_ZB, 2, (size_t)256 * 256 * 2, (size_t)256 * 256 * 2, 0, (size_t)512 * 256 * 2);
          EpiVT E{wsp<bf16>(F, WS_VT), 0}; pg8::gemm_phase<EpiVT, pg8::Order, true>(ring, g, S, E); }
        { const int b = F.vcu >> 3, h = F.vcu & 7;
          if (F.vcu < 256) {
            const attn_body::bf16* base = (const attn_body::bf16*)H1 + (size_t)b * TPB * H1E_P;
            for (int qb = 0; qb < 8; ++qb) { attn_body::AttnJob J;
                J.Q = base + (size_t)(CTXL + 256 * qb) * H1E_P + h * 64; J.K = base + 512 + h * 64; J.V = base + 1024 + h * 64;
                J.O = (attn_body::bf16*)OBE + ((size_t)b * TPB + CTXL + 256 * qb) * 1024 + 512 + h * 64; J.qp = H1E_P; J.kvp = H1E_P; J.op = 1024;
                J.NT = (qb == 0 || qb == 7) ? 12 : 16; J.KR0 = (qb == 0) ? 0 : ((qb == 7) ? 24 : 4 * qb - 4); J.qb = qb; J.BT = wsp<const float>(F, WS_BTG) + (size_t)h * 17 * 4096;
                attn_body::attn_unit<1, 8>(J, (char*)lds + RING_OFF); }
            { attn_body::AttnJob J; J.Q = base + h * 64; J.K = base + 512 + h * 64; J.V = base + 1024 + h * 64; J.O = (attn_body::bf16*)OBE + ((size_t)b * TPB) * 1024 + 512 + h * 64;
              J.qp = H1E_P; J.kvp = H1E_P; J.op = 1024; J.NT = 4; J.KR0 = 0; J.qb = 0; J.BT = nullptr; attn_body::attn_unit<0, 8>(J, (char*)lds + RING_OFF); } } }
    }
    SEAM(4);
    if (IN(5)) { pg8::Gemm g{wsp<const bf16>(F, WS_VT), wsp<const bf16>(F, WS_FC), 1024, 512, 512}; pg8::Order S; S.init(2 * NPAN, 1, F.G, bx, pg8::OM_ZAB, NPAN, (size_t)256 * 1024 * 2, 0, (size_t)512 * 2, 0);
        EpiPlainBf16 E{OBE, 1024, 0, 0, 256}; pg8::gemm_phase<EpiPlainBf16, pg8::Order, true>(ring, g, S, E); }
    SEAM(5);
    if (IN(6)) REPS(6) { pg8::Gemm g{OBE, wsp<const bf16>(F, WS_WOE), 1024, 1024, 1024}; pg8::Order S; S.init(NPAN, 4, F.G, bx, pg8::OM_PLAIN, NPAN, (size_t)256 * 1024 * 2, (size_t)256 * 1024 * 2, 0, 0);
        EpiResid<true> E{F.in[0], F.in[2], F.XL, F.XC, MOD0, 2}; pg8::gemm_phase<EpiResid<true>, pg8::Order, true>(ring, g, S, E); }
    SEAM(6);
    if (IN(7)) norm_phase<1, true>(F, F.XL, F.XC, F.in[7], 0, 3);
    SEAM(7);
    if (IN(8)) REPS(8) { pg8::Gemm g{HN, wsp<const bf16>(F, WS_W13E), 1024, 1024, 1024}; pg8::Order S; S.init(NPAN, 22, F.G, bx, pg8::OM_PLAIN, NPAN, (size_t)256 * 1024, (size_t)256 * 1024, 0, 0);
        EpiSwiglu<false> E{wsp<unsigned char>(F, WS_HMID), DFF, 0, 0.03125f, 0.03125f}; pg8::gemm_phase<EpiSwiglu<false>, pg8::Order, true, true>(ring, g, S, E); }
    SEAM(8);
    if (IN(9)) { pg8::Gemm g{wsp<const bf16>(F, WS_HMID), wsp<const bf16>(F, WS_W2E), DFF, DFF, DFF}; pg8::Order S; S.init(NPAN, 4, F.G, bx, pg8::OM_PLAIN, NPAN, (size_t)256 * DFF * 2, (size_t)256 * DFF * 2, 0, 0);
        EpiResid<false> E{F.XL, F.XC, F.XL, F.XC, MOD0, 5}; pg8::gemm_phase<EpiResid<false>, pg8::Order, true>(ring, g, S, E); }
    SEAM(9);
    if (IN(10)) norm_phase<1, true>(F, F.XL, F.XC, F.in[18], 1, 0);
    SEAM(10);
    if (IN(11)) {
        { pg8::Gemm g{HN, wsp<const bf16>(F, WS_WINO), 1024, 1024, 1024}; pg8::Order S; S.init(NPAN, 6, F.G, bx, pg8::OM_PLAIN, NPAN, (size_t)256 * 1024, (size_t)256 * 1024, 0, 0);
          EpiQKV<true> E{H1, wsp<bf16>(F, WS_AB), F.in[21], F.in[22], wsp<const float>(F, WS_ROPE), wsp<const float>(F, WS_ROPE) + 2048 * 32, (LAS float*)(F.lds + LDSCTL_OFF + 1024), 0.03125f, 0};
          pg8::gemm_phase<EpiQKV<true>, pg8::Order, true, true>(ring, g, S, E); }
    }
    SEAM(11);
    if (IN(12)) {
#define GQA_UNITS(i0, i1) for (int i = (i0); i < (i1) && i * F.G + F.vcu < NB * 12 * 8; ++i) { const int id = i * F.G + F.vcu, qb = id & 7, gq = (id >> 3) & 3, bh = id >> 5, b = bh / 3, hk = bh % 3, h = hk * 4 + gq; \
            const attn_body::bf16* base = (const attn_body::bf16*)H1 + (size_t)b * TPB * H1O_P; attn_body::AttnJob J; \
            J.Q = base + (size_t)(CTXL + 256 * qb) * H1O_P + h * 64; J.K = base + 768 + hk * 64; J.V = base + 960 + hk * 64; \
            J.O = (attn_body::bf16*)OB + ((size_t)b * TPB + CTXL + 256 * qb) * 1024 + h * 64; J.qp = H1O_P; J.kvp = H1O_P; J.op = 1024; J.NT = 36; J.KR0 = 0; J.qb = 0; J.BT = nullptr; \
            attn_body::attn_unit<0, 8>(J, (char*)lds + RING_OFF); }
        const int nq = (NB * 12 * 8 + F.G - 1) / F.G, q1 = nq / 3, q2 = (2 * nq) / 3;
        { pg8::Gemm g{wsp<const bf16>(F, WS_AB), wsp<const bf16>(F, WS_PST), 512, 256, 256}; pg8::Order S; S.init(16 * 18, 1, F.G, bx, pg8::OM_ZAB, 18, (size_t)256 * 512 * 2, (size_t)256 * 256 * 2, (size_t)4608 * 512 * 2, (size_t)256 * 256 * 2);
          EpiPlainBf16 E{wsp<bf16>(F, WS_S), 256, 4608, 0, 0}; pg8::gemm_phase<EpiPlainBf16, pg8::Order, true>(ring, g, S, E); }
        FLAG_ARRIVE(0);
        GQA_UNITS(0, q1)
        FLAG_WAIT(0);
        s5_scan_phase(F);
        FLAG_ARRIVE(1);
        GQA_UNITS(q1, q2)
        FLAG_WAIT(1);
        { pg8::Gemm g{wsp<const bf16>(F, WS_AB), wsp<const bf16>(F, WS_MQT), 512, 512, 512}; pg8::Order S; S.init(16 * 18, 1, F.G, (bx + 64) % F.G, pg8::OM_ZAB, 18, (size_t)256 * 512 * 2, (size_t)256 * 512 * 2, (size_t)4608 * 512 * 2, (size_t)256 * 512 * 2);
          EpiS5B E{wsp<const bf16>(F, WS_AB), F.in[30], wsp<bf16>(F, WS_Z)}; pg8::gemm_phase<EpiS5B, pg8::Order, true>(ring, g, S, E); }
        FLAG_ARRIVE(2);
        GQA_UNITS(q2, nq)
        FLAG_WAIT(2);
        { pg8::Gemm g{wsp<const bf16>(F, WS_Z), wsp<const bf16>(F, WS_GLUW), 256, 256, 256}; pg8::Order S; S.init(256, 1, F.G, bx, pg8::OM_LAT, 256, (size_t)256 * 256 * 2, (size_t)256 * 256 * 2, 0, 0);
          EpiGLU E{wsp<const bf16>(F, WS_Z), F.in[32], OB}; pg8::gemm_phase<EpiGLU, pg8::Order, true>(ring, g, S, E); }
#undef GQA_UNITS
    }
    if (IN(12) && IN(16)) GRID_BAR();

    if (IN(16)) { pg8::Gemm g{OB, wsp<const bf16>(F, WS_WOO), 1024, 1024, 1024}; pg8::Order S; S.init(256, 4, F.G, bx, pg8::OM_LAT, 256, (size_t)256 * 1024 * 2, (size_t)256 * 1024 * 2, 0, 0);
        EpiResid<false> E{F.XL, F.XC, F.XL, F.XC, MOD1, 2}; pg8::gemm_phase<EpiResid<false>, pg8::Order, true>(ring, g, S, E); }
    SEAM(16);
    if (IN(17)) { router_phase(F); }
    SEAM(17);
    if (IN(18)) REPS(18) { gather_phase(F); }
    SEAM(18);
    if (IN(19)) REPS(19) { const int ptot = (int)__builtin_amdgcn_readfirstlane(__hip_atomic_load(F.ctl + CW_CHUNK + 1, RLX_AGENT));
        pg8::Gemm g{wsp<const bf16>(F, WS_HNG), wsp<const bf16>(F, WS_EW13), 1024, 1024, 1024}; pg8::Order S; S.init(ptot, 28, F.G, bx, pg8::OM_MOE, ptot, (size_t)256 * 1024, (size_t)256 * 1024, 0, (size_t)7168 * 1024);
        S.pexp = F.ctl + CW_PEXP; S.pbase = 0; S.apan0 = 0;
        EpiSwiglu<true> E{wsp<unsigned char>(F, WS_HME), DFE, 0, 0.03125f, 0.25f}; pg8::gemm_phase<EpiSwiglu<true>, pg8::Order, true, true>(ring, g, S, E); }
    SEAM(19);
#define MOE_DOWN(half, ph) \
    if (IN(ph)) { const int p0 = (int)__builtin_amdgcn_readfirstlane(__hip_atomic_load(F.ctl + CW_CHUNK, RLX_AGENT)), pt = (int)__builtin_amdgcn_readfirstlane(__hip_atomic_load(F.ctl + CW_CHUNK + 1, RLX_AGENT)); \
        const int cbase = (half) ? p0 : 0, cnp = (half) ? pt - p0 : p0; \
        pg8::Gemm g{wsp<const bf16>(F, WS_HME), wsp<const bf16>(F, WS_EW2), DFE, DFE, DFE}; pg8::Order S; S.init(cnp, 4, F.G, bx, pg8::OM_MOE, cnp, (size_t)256 * DFE, (size_t)256 * DFE, 0, (size_t)1024 * DFE); \
        S.pexp = F.ctl + CW_PEXP; S.pbase = cbase; S.apan0 = cbase; \
        EpiMoe2<(half) != 0> E{(half) ? F.X3P : F.XL, (half) ? (void*)F.OUT : (void*)F.X3P, wsp<const int>(F, WS_STOK), wsp<const float>(F, WS_SW), MOD1}; pg8::gemm_phase<EpiMoe2<(half) != 0>, pg8::Order, true, true>(ring, g, S, E); }
    MOE_DOWN(0, 20) SEAM(20);
    MOE_DOWN(1, 21)
#undef MOE_DOWN
#undef IN
#undef SEAM
}

extern "C" void kernel_launch(void* const* d_in, const int* in_sizes, int n_in, void* d_out, int out_size, void* d_ws, size_t ws_size, hipStream_t stream) {
    static int grid = 0;
    if (grid == 0) {
        if (n_in != 39 || out_size != MLAT * D || ws_size < WS_END) { fprintf(stderr, "kernel_launch: unexpected shapes (n_in %d, out %d, ws %zu)\n", n_in, out_size, ws_size); grid = -1; return; }
        int dev = 0, cus = 0, per_cu = 0;
        if (hipGetDevice(&dev) != hipSuccess || hipDeviceGetAttribute(&cus, hipDeviceAttributeMultiprocessorCount, dev) != hipSuccess) { grid = -1; return; }
        if (hipFuncSetAttribute((const void*)mk_fwd, hipFuncAttributeMaxDynamicSharedMemorySize, LDS_BYTES) != hipSuccess) { fprintf(stderr, "kernel_launch: hipFuncSetAttribute failed\n"); grid = -1; return; }
        if (hipOccupancyMaxActiveBlocksPerMultiprocessor(&per_cu, (const void*)mk_fwd, NWAVES * 64, LDS_BYTES) != hipSuccess || per_cu < 1)
            fprintf(stderr, "kernel_launch: note: occupancy query reports %d workgroups per CU\n", per_cu);
        (void)hipGetLastError();
        grid = cus;
    }
    if (grid < 0) return;
    if (hipMemsetAsync((char*)d_ws + WS_CTL, 0, CTL_ZERO_BYTES, stream) != hipSuccess) return;
    Args a{};
    for (int i = 0; i < 39; ++i) a.in[i] = (const float*)d_in[i];
    a.out = (float*)d_out; a.ws = (unsigned char*)d_ws; a.pad = 0;
#if MK_PER_PHASE
    for (int li = 0; li < NPH; ++li) { a.ph_lo = li; a.ph_hi = li + 1; a.li = li; hipLaunchKernelGGL(mk_fwd, dim3(grid), dim3(NWAVES * 64), LDS_BYTES, stream, a); }
#else
    a.ph_lo = 0; a.ph_hi = NPH; a.li = 0;
    hipLaunchKernelGGL(mk_fwd, dim3(grid), dim3(NWAVES * 64), LDS_BYTES, stream, a);
#endif
}
```

```cpp
#include <hip/hip_runtime.h>
#include <hip/hip_bf16.h>
#include <cstdio>
#include <cstdint>
#include <cmath>

#ifndef MK_PER_PHASE
#define MK_PER_PHASE 0
#endif

namespace pg8 {
#define PG8_LAS __attribute__((address_space(3)))
typedef unsigned short bf16_t;
typedef short bf16x8 __attribute__((ext_vector_type(8)));
typedef float f32x4 __attribute__((ext_vector_type(4)));
typedef unsigned u32x4 __attribute__((ext_vector_type(4)));
typedef unsigned u32x2 __attribute__((ext_vector_type(2)));
typedef int i32x4 __attribute__((ext_vector_type(4)));
typedef int i32x8 __attribute__((ext_vector_type(8)));
constexpr int BM = 256, BK = 64, HALF = 128, HTB = HALF * BK * 2, STAGE_BYTES = 8 * HTB, NXCD = 8, WGM = 8;

__host__ __device__ __forceinline__ int lds_byte(int r, int c) { const int st = (r >> 4) * 2 + (c >> 5), rr = r & 15, cc = c & 31, ob = rr * 64 + cc * 2; return st * 1024 + (ob ^ (((ob >> 9) & 1) << 5)); }
__host__ __device__ __forceinline__ void stage_rc(int b, int& R, int& C) { const int st = b / 1024, sb = b % 1024, swz = sb ^ (((sb >> 9) & 1) << 5); R = (st >> 1) * 16 + swz / 64; C = (st & 1) * 32 + (swz % 64) / 2; }
__host__ __device__ __forceinline__ int perm32(int rho) { const int n = rho >> 4, i = rho & 15; return 8 * (i >> 2) + 4 * n + (i & 3); }

struct Unit { int pm, pn, z, aux; size_t aoff, boff; };
struct Gemm { const bf16_t* A; const bf16_t* Bt; int lda, ldb, K; };

enum { OM_PLAIN = 0, OM_LAT = 1, OM_ZB = 2, OM_ZAB = 3, OM_MOE = 4 };
struct Order {
    int nM, nN, nwg, G, c, mode, nMz, pbase, apan0; size_t tA, tB, zA, zB; const unsigned* pexp;
    __device__ __forceinline__ void init(int nM_, int nN_, int G_, int c_, int mode_, int nMz_, size_t tA_, size_t tB_, size_t zA_, size_t zB_) {
        nM = nM_; nN = nN_; nwg = nM_ * nN_; G = G_; c = c_; mode = mode_; nMz = nMz_; tA = tA_; tB = tB_; zA = zA_; zB = zB_; pexp = nullptr; pbase = 0; apan0 = 0; }
    __device__ __forceinline__ bool next(int i, Unit& u) const {
        const long L = (long)i * G + c; if (L >= nwg) return false;
        int wgid = (int)L; { const int q = nwg / NXCD, r = nwg % NXCD, xcd = wgid % NXCD, off = wgid / NXCD; wgid = (xcd < r ? xcd * (q + 1) : r * (q + 1) + (xcd - r) * q) + off; }
        const int nig = WGM * nN, gid = wgid / nig, fm = gid * WGM, gsz = (nM - fm) < WGM ? (nM - fm) : WGM;
        const int pmz = fm + ((wgid % nig) % gsz), pn = (wgid % nig) / gsz;
        u.pn = pn; u.aux = pmz;
        if (mode == OM_PLAIN) { u.z = 0; u.pm = pmz; u.aoff = (size_t)pmz * tA; u.boff = (size_t)pn * tB; }
        else if (mode == OM_LAT) { u.z = 0; u.pm = (pmz >> 3) * 9 + 1 + (pmz & 7); u.aoff = (size_t)u.pm * tA; u.boff = (size_t)pn * tB; }
        else if (mode == OM_ZB) { u.z = pmz / nMz; u.pm = pmz % nMz; u.aoff = (size_t)u.pm * tA; u.boff = (size_t)u.z * zB + (size_t)pn * tB; }
        else if (mode == OM_ZAB) { u.z = pmz / nMz; u.pm = pmz % nMz; u.aoff = (size_t)u.z * zA + (size_t)u.pm * tA; u.boff = (size_t)u.z * zB + (size_t)pn * tB; }
        else { u.pm = pbase + pmz; u.z = (int)__builtin_amdgcn_readfirstlane(__hip_atomic_load(pexp + u.pm, __ATOMIC_RELAXED, __HIP_MEMORY_SCOPE_AGENT));
               u.aoff = (size_t)(apan0 + pmz) * tA; u.boff = (size_t)u.z * zB + (size_t)pn * tB; }
        return true;
    }
    __device__ __forceinline__ void a_ready(const Unit&) const {}
    __device__ __forceinline__ void done(const Unit&) const {}
};

__device__ __forceinline__ unsigned cvt_pk_bf16(float lo, float hi) { unsigned r; asm volatile("v_cvt_pk_bf16_f32 %0, %1, %2" : "=v"(r) : "v"(lo), "v"(hi)); return r; }

template <class Epi, class Sched, bool ALIGN_EPI, bool FP8 = false>
__device__ __forceinline__ void gemm_phase(PG8_LAS unsigned char* lds, const Gemm g, const Sched& S, const Epi& E) {
    const int tid = threadIdx.x, wid = __builtin_amdgcn_readfirstlane(tid >> 6), lane = tid & 63, wr = wid >> 2, wc = wid & 3, fr = lane & 15, fq = lane >> 4;
    constexpr int ESZ = FP8 ? 1 : 2;
    const int nt = FP8 ? g.K / (2 * BK) : g.K / BK;
    unsigned voffA[2], voffB[2];
#pragma unroll
    for (int i = 0; i < 2; ++i) { int R, C; stage_rc(tid * 16 + i * 8192, R, C); const int Rb = Epi::PERM ? ((R & ~31) + perm32(R & 31)) : R;
        voffA[i] = (unsigned)(R * g.lda * ESZ + C * 2); voffB[i] = (unsigned)(Rb * g.ldb * ESZ + C * 2); }
    const size_t kstep = (size_t)(BK * 2);
    const size_t hstepA = (size_t)HALF * g.lda * ESZ, hstepB = (size_t)HALF * g.ldb * ESZ;
    const unsigned ldsw = (unsigned)wid * 1024u;
    const int aoff = lds_byte(wr * 64 + fr, fq * 8), boff = lds_byte(wc * 32 + fr, fq * 8);
#define PG8_SA(b, h) (((b) * 2 + (h)) * HTB)
#define PG8_SB(b, h) ((4 + (b) * 2 + (h)) * HTB)
#define PG8_STAGE(bufoff, gbase, voff) do { _Pragma("unroll") for (int _i = 0; _i < 2; ++_i) \
        __builtin_amdgcn_global_load_lds((const unsigned*)((const char*)(gbase) + (voff)[_i]), (PG8_LAS unsigned*)(lds + (bufoff) + ldsw + _i * 8192), 16, 0, 0); } while (0)
#define PG8_LDA(dst, b, h) do { _Pragma("unroll") for (int m = 0; m < 4; ++m) { if constexpr (FP8) { const i32x4 lo_ = *(const PG8_LAS i32x4*)(lds + PG8_SA(b, h) + aoff + m * 2048), hi_ = *(const PG8_LAS i32x4*)(lds + PG8_SA(b, h) + aoff + m * 2048 + 1024); \
        dst##8[m] = __builtin_shufflevector(lo_, hi_, 0, 1, 2, 3, 4, 5, 6, 7); } else { _Pragma("unroll") for (int k = 0; k < 2; ++k) dst[m][k] = *(const PG8_LAS bf16x8*)(lds + PG8_SA(b, h) + aoff + m * 2048 + k * 1024); } } } while (0)
#define PG8_LDB(dst, b, h) do { _Pragma("unroll") for (int n = 0; n < 2; ++n) { if constexpr (FP8) { const i32x4 lo_ = *(const PG8_LAS i32x4*)(lds + PG8_SB(b, h) + boff + n * 2048), hi_ = *(const PG8_LAS i32x4*)(lds + PG8_SB(b, h) + boff + n * 2048 + 1024); \
        dst##8[n] = __builtin_shufflevector(lo_, hi_, 0, 1, 2, 3, 4, 5, 6, 7); } else { _Pragma("unroll") for (int k = 0; k < 2; ++k) dst[n][k] = *(const PG8_LAS bf16x8*)(lds + PG8_SB(b, h) + boff + n * 2048 + k * 1024); } } } while (0)
#define PG8_MMA(ai, bj, At, Bt) do { __builtin_amdgcn_s_setprio(1); _Pragma("unroll") for (int m = 0; m < 4; ++m) _Pragma("unroll") for (int n = 0; n < 2; ++n) { \
        if constexpr (FP8) { asm volatile("v_mfma_f32_16x16x128_f8f6f4 %0, %1, %2, %0" : "+v"(acc[ai][bj][m][n]) : "v"(Bt##8[n]), "v"(At##8[m])); } \
        else { _Pragma("unroll") for (int k = 0; k < 2; ++k) acc[ai][bj][m][n] = __builtin_amdgcn_mfma_f32_16x16x32_bf16(Bt[n][k], At[m][k], acc[ai][bj][m][n], 0, 0, 0); } } \
        __builtin_amdgcn_s_setprio(0); } while (0)
#define PG8_WAIT_V(n) asm volatile("s_waitcnt vmcnt(" #n ")" ::: "memory")
#define PG8_WAIT_L(n) asm volatile("s_waitcnt lgkmcnt(" #n ")" ::: "memory")
#define PG8_BAR __builtin_amdgcn_s_barrier()
#define PG8_SCHED __builtin_amdgcn_sched_barrier(0)
    Unit cur, nxt; int ui = 0;
    if (!S.next(0, cur)) return;
    f32x4 acc[2][2][4][2];
#pragma unroll
    for (int a = 0; a < 2; ++a)
#pragma unroll
        for (int b = 0; b < 2; ++b)
#pragma unroll
            for (int m = 0; m < 4; ++m)
#pragma unroll
                for (int n = 0; n < 2; ++n) acc[a][b][m][n] = (f32x4){0.f, 0.f, 0.f, 0.f};
    bf16x8 At[4][2], B0[2][2], B1[2][2]; i32x8 At8[4], B08[2], B18[2];
    const char* cA = (const char*)g.A + cur.aoff; const char* cB = (const char*)g.Bt + cur.boff;
    S.a_ready(cur);
    PG8_STAGE(PG8_SB(0, 0), cB, voffB); PG8_STAGE(PG8_SB(0, 1), cB + hstepB, voffB); PG8_STAGE(PG8_SA(0, 0), cA, voffA); PG8_STAGE(PG8_SA(0, 1), cA + hstepA, voffA);
    if (wr == 1) PG8_BAR;
    PG8_WAIT_V(2); PG8_BAR;
    PG8_STAGE(PG8_SB(1, 0), cB + kstep, voffB); PG8_STAGE(PG8_SA(1, 0), cA + kstep, voffA); PG8_STAGE(PG8_SB(1, 1), cB + hstepB + kstep, voffB);
    PG8_WAIT_V(6); PG8_BAR;
    for (;;) {
        const bool has_next = S.next(ui + 1, nxt);
        const char* nA = has_next ? (const char*)g.A + nxt.aoff : cA; const char* nB = has_next ? (const char*)g.Bt + nxt.boff : cB;
#pragma unroll 1
        for (int t = 0; t < nt; t += 2) {
            const bool last = (t == nt - 2);
            const char* a1 = cA + (size_t)(t + 1) * kstep;
            const char* a2 = last ? nA : cA + (size_t)(t + 2) * kstep; const char* b2 = last ? nB : cB + (size_t)(t + 2) * kstep;
            const char* a3 = a2 + kstep; const char* b3 = b2 + kstep;
            if (last && has_next) S.a_ready(nxt);
            PG8_LDB(B0, 0, 0); PG8_LDB(B1, 0, 1); PG8_SCHED; PG8_LDA(At, 0, 0); PG8_STAGE(PG8_SA(1, 1), a1 + hstepA, voffA);
            PG8_WAIT_V(8); PG8_WAIT_L(0); PG8_BAR; PG8_MMA(0, 0, At, B0); PG8_MMA(0, 1, At, B1); PG8_BAR; PG8_SCHED;
            PG8_LDA(At, 0, 1); PG8_STAGE(PG8_SB(0, 0), b2, voffB); PG8_STAGE(PG8_SB(0, 1), b2 + hstepB, voffB); PG8_STAGE(PG8_SA(0, 0), a2, voffA);
            PG8_WAIT_V(8); PG8_WAIT_L(0); PG8_BAR; PG8_MMA(1, 0, At, B0); PG8_MMA(1, 1, At, B1); PG8_BAR; PG8_SCHED;
            PG8_LDB(B0, 1, 0); PG8_LDB(B1, 1, 1); PG8_SCHED; PG8_LDA(At, 1, 0); PG8_STAGE(PG8_SA(0, 1), a2 + hstepA, voffA);
            PG8_WAIT_V(8); PG8_WAIT_L(0); PG8_BAR; PG8_MMA(0, 0, At, B0); PG8_MMA(0, 1, At, B1); PG8_BAR; PG8_SCHED;
            PG8_LDA(At, 1, 1); PG8_STAGE(PG8_SB(1, 0), b3, voffB); PG8_STAGE(PG8_SB(1, 1), b3 + hstepB, voffB); PG8_STAGE(PG8_SA(1, 0), a3, voffA);
            PG8_WAIT_V(8); PG8_WAIT_L(0); PG8_BAR; PG8_MMA(1, 0, At, B0); PG8_MMA(1, 1, At, B1); PG8_BAR; PG8_SCHED;
        }
        if constexpr (ALIGN_EPI) { if (wr == 0) PG8_BAR; }
        if constexpr (FP8) asm volatile("s_nop 15\n\ts_nop 7" ::: "memory");
        E(acc, cur, wr, wc, fr, fq); S.done(cur);
        if (!has_next) break;
#pragma unroll
        for (int a = 0; a < 2; ++a)
#pragma unroll
            for (int b = 0; b < 2; ++b)
#pragma unroll
                for (int m = 0; m < 4; ++m)
#pragma unroll
                    for (int n = 0; n < 2; ++n) acc[a][b][m][n] = (f32x4){0.f, 0.f, 0.f, 0.f};
        cur = nxt; cA = nA; cB = nB; ++ui;
        if constexpr (ALIGN_EPI) { if (wr == 1) PG8_BAR; }
    }
    PG8_WAIT_V(0);
    if constexpr (!ALIGN_EPI) { if (wr == 0) PG8_BAR; }
    PG8_BAR;
#undef PG8_SA
#undef PG8_SB
#undef PG8_STAGE
#undef PG8_LDA
#undef PG8_LDB
#undef PG8_MMA
#undef PG8_WAIT_V
#undef PG8_WAIT_L
#undef PG8_BAR
#undef PG8_SCHED
}
}

namespace attn_body {
using bf16=__hip_bfloat16;
using bf16x8=__attribute__((ext_vector_type(8)))short;
using s16x4=__attribute__((ext_vector_type(4)))short;
using f32x16=__attribute__((ext_vector_type(16)))float;
using u32x4=__attribute__((ext_vector_type(4)))unsigned;
constexpr int D=64;
constexpr int NW=8,QBLK=32,QB=QBLK*NW,KVBLK=64;
__device__ __forceinline__ int crow(int r,int hi){return (r&3)+8*(r>>2)+4*hi;}
#define SBAR() __builtin_amdgcn_sched_barrier(0)
constexpr int NSLOT=3, SLOTB=8192;
constexpr int LDS_K=0, LDS_V=NSLOT*SLOTB, LDS_WS=2*NSLOT*SLOTB, LDS_OST=LDS_WS+NW*64*4, LDS_BYTES=LDS_OST+NW*4096;
constexpr int LDS_BT=86016;
constexpr int NA_KINDS=17, NA_KIND_CTX=15, NA_KIND_NONE=16;
__device__ __forceinline__ void glds16(const void*gsrc,unsigned lds_dst){unsigned keep;
  asm volatile("s_mov_b32 %0, m0\n\ts_mov_b32 m0, %2\n\ts_nop 0\n\tglobal_load_lds_dwordx4 %1, off\n\ts_mov_b32 m0, %0":"=&s"(keep):"v"(gsrc),"s"(lds_dst):"memory");}
__device__ __forceinline__ float max3f(float a,float b,float c){float r;asm("v_max3_f32 %0, %1, %2, %3":"=v"(r):"v"(a),"v"(b),"v"(c));return r;}
__device__ __forceinline__ float max2f(float a,float b){float r;asm("v_max_f32_e32 %0, %1, %2":"=v"(r):"v"(a),"v"(b));return r;}
__device__ __forceinline__ float fadd_s(float a,float b){float r;asm("v_add_f32_e32 %0, %1, %2":"=v"(r):"v"(a),"v"(b));return r;}
__device__ __forceinline__ float fsub_s(float a,float b){float r;asm("v_sub_f32_e32 %0, %1, %2":"=v"(r):"v"(a),"v"(b));return r;}
typedef float f32x2_t __attribute__((ext_vector_type(2))); typedef float f32x4_t __attribute__((ext_vector_type(4))); typedef __bf16 bf16x2_t __attribute__((ext_vector_type(2)));
__device__ __forceinline__ unsigned cvtpk_s(float lo,float hi){f32x2_t v={lo,hi};bf16x2_t b=__builtin_convertvector(v,bf16x2_t);return __builtin_bit_cast(unsigned,b);}
#define WAIT_BAR(N) asm volatile("s_waitcnt vmcnt(" #N ") lgkmcnt(0)\n\ts_barrier":::"memory")

__device__ __forceinline__ void qkt(f32x16&p0,f32x16&p1,const char*Kslot,const bf16x8*qr,const f32x16&negm,int r32,int hi){
  const char*kb=Kslot+hi*1024+r32*16;
  #pragma unroll
  for(int d0=0;d0<4;++d0){
    const bf16x8 b0=*reinterpret_cast<const bf16x8*>(kb+d0*2048);
    const bf16x8 b1=*reinterpret_cast<const bf16x8*>(kb+d0*2048+512);
    if(d0==0){p0=__builtin_amdgcn_mfma_f32_32x32x16_bf16(b0,qr[0],negm,0,0,0);p1=__builtin_amdgcn_mfma_f32_32x32x16_bf16(b1,qr[0],negm,0,0,0);}
    else{p0=__builtin_amdgcn_mfma_f32_32x32x16_bf16(b0,qr[d0],p0,0,0,0);p1=__builtin_amdgcn_mfma_f32_32x32x16_bf16(b1,qr[d0],p1,0,0,0);}}
}
typedef __attribute__((address_space(3))) const char* lds_cptr;
typedef __attribute__((address_space(3))) const float* lds_fptr;
typedef short v4i16_t __attribute__((ext_vector_type(4)));
__device__ __forceinline__ void kload8(bf16x8*kf,lds_cptr kp){
  kf[0]=*(const __attribute__((address_space(3))) bf16x8*)(kp);      kf[1]=*(const __attribute__((address_space(3))) bf16x8*)(kp+512);
  kf[2]=*(const __attribute__((address_space(3))) bf16x8*)(kp+2048); kf[3]=*(const __attribute__((address_space(3))) bf16x8*)(kp+2560);
  kf[4]=*(const __attribute__((address_space(3))) bf16x8*)(kp+4096); kf[5]=*(const __attribute__((address_space(3))) bf16x8*)(kp+4608);
  kf[6]=*(const __attribute__((address_space(3))) bf16x8*)(kp+6144); kf[7]=*(const __attribute__((address_space(3))) bf16x8*)(kp+6656);
}
__device__ __forceinline__ void kload2(bf16x8*kf,lds_cptr kp,int j){ kf[2*j]=*(const __attribute__((address_space(3))) bf16x8*)(kp+j*2048); kf[2*j+1]=*(const __attribute__((address_space(3))) bf16x8*)(kp+j*2048+512); }
__device__ __forceinline__ s16x4 vtr(lds_cptr p){ return __builtin_bit_cast(s16x4,__builtin_amdgcn_ds_read_tr16_b64_v4i16((__attribute__((address_space(3))) v4i16_t*)p)); }
__device__ __forceinline__ float rowmax(const f32x16&p0,const f32x16&p1){
  float a=max3f(p0[0],p0[1],p1[0]),b=max3f(p0[2],p0[3],p1[1]);a=max3f(a,p1[2],p1[3]);
  #pragma unroll
  for(int r=4;r<16;r+=4){a=max3f(a,p0[r],p0[r+1]);b=max3f(b,p0[r+2],p0[r+3]);a=max3f(a,p1[r],p1[r+1]);b=max3f(b,p1[r+2],p1[r+3]);}
  const float m=max2f(a,b);
  auto rr=__builtin_amdgcn_permlane32_swap(__float_as_uint(m),__float_as_uint(m),false,false);
  return max2f(__uint_as_float(rr[0]),__uint_as_float(rr[1]));
}
__device__ __forceinline__ void pv(f32x16*o,int vb,bf16x8 pa0,bf16x8 pa1,bf16x8 pa2,bf16x8 pa3){
  #pragma unroll
  for(int d0=0;d0<2;++d0){s16x4 lo[4],hi[4];
    #pragma unroll
    for(int ks=0;ks<4;++ks){
      asm volatile("ds_read_b64_tr_b16 %0,%1 offset:%c2":"=&v"(lo[ks]):"v"(vb),"i"(d0*4096+ks*1024):"memory");
      asm volatile("ds_read_b64_tr_b16 %0,%1 offset:%c2":"=&v"(hi[ks]):"v"(vb),"i"(d0*4096+ks*1024+512):"memory");}
    asm volatile("s_waitcnt lgkmcnt(0)":::"memory");SBAR();
    #define PK(k) (bf16x8){lo[k][0],lo[k][1],lo[k][2],lo[k][3],hi[k][0],hi[k][1],hi[k][2],hi[k][3]}
    o[d0]=__builtin_amdgcn_mfma_f32_32x32x16_bf16(pa0,PK(0),o[d0],0,0,0);
    o[d0]=__builtin_amdgcn_mfma_f32_32x32x16_bf16(pa1,PK(1),o[d0],0,0,0);
    o[d0]=__builtin_amdgcn_mfma_f32_32x32x16_bf16(pa2,PK(2),o[d0],0,0,0);
    o[d0]=__builtin_amdgcn_mfma_f32_32x32x16_bf16(pa3,PK(3),o[d0],0,0,0);
    #undef PK
  }
}
struct AttnJob { const bf16* Q; const bf16* K; const bf16* V; bf16* O; int qp, kvp, op, NT, KR0, qb; const float* BT; float mfix; };
#ifndef ATTN_STORE16
#define ATTN_STORE16(p,v) (*(u32x4*)(p)=(v))
#endif
template<int MODE,int THRL> __device__ __forceinline__ void attn_unit(const AttnJob&J,char*shm){
  const int tid=threadIdx.x,lane=tid&63,r32=lane&31,hi=lane>>5; const int wid=__builtin_amdgcn_readfirstlane(tid>>6);
  const int qp=J.qp,kvp=J.kvp,op=J.op,KR0=J.KR0;
  const bf16*Qw=J.Q+(long)(wid*QBLK)*qp;
  const unsigned lds0=(unsigned)(uintptr_t)shm;
  float*wsf=(float*)(shm+LDS_WS)+wid*64;
  const bf16*ksrc=J.K+(long)lane*kvp+wid*8;
  const bf16*vsrc=J.V+(long)(16*(wid&3)+(lane>>2))*kvp+(wid>>2)*32+(lane&3)*8;
  const unsigned kdst=lds0+LDS_K+wid*1024, vdst=lds0+LDS_V+wid*1024;
  #define TROW(t) ((MODE==1&&(t)>=4)?((t)+KR0)*KVBLK:(t)*KVBLK)
  #define DMA_K(t,slot) glds16(ksrc+(long)TROW(t)*kvp,(unsigned)__builtin_amdgcn_readfirstlane(kdst+(slot)))
  #define DMA_V(t,slot) glds16(vsrc+(long)TROW(t)*kvp,(unsigned)__builtin_amdgcn_readfirstlane(vdst+(slot)))
  const int vb0=(int)(lds0+LDS_V)+((lane>>4)&1)*32+(lane&3)*8+(4*hi+((lane&15)>>2))*64;
  const char*Kbase=shm+LDS_K; bf16x8 kf[8];
  const lds_cptr shm3=(lds_cptr)shm; const lds_cptr kp0=shm3+LDS_K+hi*1024+r32*16; const lds_cptr vp0=shm3+LDS_V+((lane>>4)&1)*32+(lane&3)*8+(4*hi+((lane&15)>>2))*64;
  const int NT=J.NT;
  const int qrow=4*J.qb+(wid>>1);
  const char*btsrc=(const char*)J.BT+(size_t)(((wid&1)*64+lane)*16);
  const unsigned btdst=lds0+LDS_BT+wid*8192;
  const lds_cptr btp=shm3+LDS_BT+wid*8192+lane*16;
  #define BTKIND(t) ((t)<4?NA_KIND_CTX:(((KR0+(t)-4)>=((qrow-4)<0?0:((qrow-4)>24?24:(qrow-4)))&&(KR0+(t)-4)<=((qrow-4)<0?0:((qrow-4)>24?24:(qrow-4)))+7)?(KR0+(t)-4-qrow+7):NA_KIND_NONE))
  #define DMA_BT(t) do{ if(MODE==1){ const char*s_=btsrc+(size_t)BTKIND(t)*16384; _Pragma("unroll") for(int j_=0;j_<8;++j_) glds16(s_+j_*2048,(unsigned)__builtin_amdgcn_readfirstlane(btdst+j_*1024)); } }while(0)
  #define BT_READ(C0,C1) do{ if(MODE==1){ _Pragma("unroll") for(int j_=0;j_<4;++j_){ const f32x4_t a_=*(const __attribute__((address_space(3))) f32x4_t*)(btp+j_*1024), b_=*(const __attribute__((address_space(3))) f32x4_t*)(btp+(j_+4)*1024); \
      C0[4*j_]=a_[0];C0[4*j_+1]=a_[1];C0[4*j_+2]=a_[2];C0[4*j_+3]=a_[3]; C1[4*j_]=b_[0];C1[4*j_+1]=b_[1];C1[4*j_+2]=b_[2];C1[4*j_+3]=b_[3]; } } }while(0)
  DMA_K(0,0);DMA_V(0,0);DMA_K(1,SLOTB);
  bf16x8 qr[4];
  #pragma unroll
  for(int d0=0;d0<4;++d0)qr[d0]=*reinterpret_cast<const bf16x8*>(&Qw[(long)r32*qp+d0*16+hi*8]);
  float mhat=J.mfix,l_reg=0.f;f32x16 o[2];o[0]=f32x16{};o[1]=f32x16{};f32x16 negm;
  #pragma unroll
  for(int r=0;r<16;++r)negm[r]=-mhat;
  asm volatile("":"+v"(negm));
  #define CMASK(P0,P1,t) do{ }while(0)
  bool resc=false;
  #define START(P0,P1) do{ resc=false; \
    _Pragma("unroll") for(int r=0;r<16;++r)P0[r]=__builtin_amdgcn_exp2f(P0[r]); }while(0)
  #define RESC() do{ if(resc){ asm volatile("s_waitcnt lgkmcnt(0)":::"memory"); \
      _Pragma("unroll") for(int d_=0;d_<2;++d_) _Pragma("unroll") for(int r=0;r<16;++r)o[d_][r]*=wsf[crow(r,hi)]; } }while(0)
  f32x16 pA0,pA1,pB0,pB1;
  int sl_prev=0,sl_cur=0,sl_next=SLOTB;
  #define ROT() do{sl_prev=sl_cur;sl_cur=sl_next;sl_next=(sl_next==(NSLOT-1)*SLOTB)?0:sl_next+SLOTB;}while(0)
  DMA_K(2,2*SLOTB);
  WAIT_BAR(3);
  qkt(pA0,pA1,Kbase,qr,negm,r32,hi);asm volatile("s_nop 15\n\ts_nop 7":"+v"(pA0),"+v"(pA1));
  START(pA0,pA1);
  _Pragma("unroll") for(int r=0;r<16;++r)pA1[r]=__builtin_amdgcn_exp2f(pA1[r]);
  WAIT_BAR(0);
  DMA_BT(1);DMA_K(3,0);DMA_V(1,SLOTB);
  ROT();
  kload8(kf,kp0+sl_cur);
  WAIT_BAR(2);
  s16x4 vlo[8],vhi[8]; u32x4 pw0,pw1,pw2,pw3;
  #define PKW(P,B) cvtpk_s(P[B],P[B+1])
  #define PAF(k) __builtin_bit_cast(bf16x8,pw##k)
  #define VFR(i) (bf16x8){vlo[i][0],vlo[i][1],vlo[i][2],vlo[i][3],vhi[i][0],vhi[i][1],vhi[i][2],vhi[i][3]}
  #define PIN(x) asm volatile("":"+v"(x))
  #define MX3(a,b,c) __builtin_fmaxf(__builtin_fmaxf((a),(b)),(c))
  #define GAPA(MF,A0,A1,A2,A3,W0,W1,PW) do{ MF; sacc+=A0; sacc+=A1; sacc+=A2; sacc+=A3; PIN(sacc); W0; W1; PIN(PW); SBAR(); }while(0)
  #define EX(v) __builtin_amdgcn_exp2f(v)
  #define GAPB(MF,X,B) do{ MF; X[B]=EX(X[B]); X[B+1]=EX(X[B+1]); X[B+2]=EX(X[B+2]); X[B+3]=EX(X[B+3]); PIN(X); SBAR(); }while(0)
  #define VRD(i) do{ vlo[i]=vtr(vp_+(((i)>>2)*4096+((i)&3)*1024)); vhi[i]=vtr(vp_+(((i)>>2)*4096+((i)&3)*1024+512)); }while(0)
  #define KRD(G,j) do{ if(G){ kload2(kf,kp0+sl_next,j); SBAR(); } }while(0)
  #define STEP(C0,C1,P0,P1,t,GK,GV,GL) do{ SBAR(); \
    const lds_cptr vp_=vp0+sl_prev; \
    BT_READ(C0,C1); VRD(0); SBAR(); float sacc=(P0[0]+P0[1]); \
    GAPA(C0=__builtin_amdgcn_mfma_f32_32x32x16_bf16(kf[0],qr[0],(MODE==1?C0:negm),0,0,0), P0[2],P0[3],P0[4],P0[5],     pw0[0]=PKW(P0,0), pw0[1]=PKW(P0,2), pw0); \
    VRD(4); SBAR(); GAPA(C1=__builtin_amdgcn_mfma_f32_32x32x16_bf16(kf[1],qr[0],(MODE==1?C1:negm),0,0,0), P0[6],P0[7],P0[8],P0[9],     pw0[2]=PKW(P0,4), pw0[3]=PKW(P0,6), pw0); \
    VRD(1); SBAR(); GAPA(C0=__builtin_amdgcn_mfma_f32_32x32x16_bf16(kf[2],qr[1],C0,0,0,0),   P0[10],P0[11],P0[12],P0[13], pw1[0]=PKW(P0,8), pw1[1]=PKW(P0,10), pw1); \
    VRD(5); SBAR(); GAPA(C1=__builtin_amdgcn_mfma_f32_32x32x16_bf16(kf[3],qr[1],C1,0,0,0),   P0[14],P0[15],P1[0],P1[1],   pw1[2]=PKW(P0,12),pw1[3]=PKW(P0,14), pw1); \
    VRD(2); SBAR(); GAPA(C0=__builtin_amdgcn_mfma_f32_32x32x16_bf16(kf[4],qr[2],C0,0,0,0),   P1[2],P1[3],P1[4],P1[5],     pw2[0]=PKW(P1,0), pw2[1]=PKW(P1,2), pw2); \
    VRD(6); SBAR(); GAPA(C1=__builtin_amdgcn_mfma_f32_32x32x16_bf16(kf[5],qr[2],C1,0,0,0),   P1[6],P1[7],P1[8],P1[9],     pw2[2]=PKW(P1,4), pw2[3]=PKW(P1,6), pw2); \
    VRD(3); SBAR(); GAPA(C0=__builtin_amdgcn_mfma_f32_32x32x16_bf16(kf[6],qr[3],C0,0,0,0),   P1[10],P1[11],P1[12],P1[13], pw3[0]=PKW(P1,8), pw3[1]=PKW(P1,10), pw3); \
    VRD(7); SBAR(); GAPA(C1=__builtin_amdgcn_mfma_f32_32x32x16_bf16(kf[7],qr[3],C1,0,0,0),   P1[14],P1[15],0.f,0.f,       pw3[2]=PKW(P1,12),pw3[3]=PKW(P1,14), pw3); \
    l_reg+=sacc; \
    if(GV){DMA_BT((t)+1);} if(GK){DMA_K((t)+3,sl_cur);} if(GV){DMA_V((t)+1,sl_next);} \
    CMASK(C0,C1,t); \
    SBAR(); \
    GAPB(o[0]=__builtin_amdgcn_mfma_f32_32x32x16_bf16(PAF(0),VFR(0),o[0],0,0,0), C0,0); \
    GAPB(o[1]=__builtin_amdgcn_mfma_f32_32x32x16_bf16(PAF(0),VFR(4),o[1],0,0,0), C0,4); \
    KRD(GL,0); GAPB(o[0]=__builtin_amdgcn_mfma_f32_32x32x16_bf16(PAF(1),VFR(1),o[0],0,0,0), C0,8); \
    KRD(GL,1); GAPB(o[1]=__builtin_amdgcn_mfma_f32_32x32x16_bf16(PAF(1),VFR(5),o[1],0,0,0), C0,12); \
    KRD(GL,2); GAPB(o[0]=__builtin_amdgcn_mfma_f32_32x32x16_bf16(PAF(2),VFR(2),o[0],0,0,0), C1,0); \
    KRD(GL,3); GAPB(o[1]=__builtin_amdgcn_mfma_f32_32x32x16_bf16(PAF(2),VFR(6),o[1],0,0,0), C1,4); \
    GAPB(o[0]=__builtin_amdgcn_mfma_f32_32x32x16_bf16(PAF(3),VFR(3),o[0],0,0,0), C1,8); \
    GAPB(o[1]=__builtin_amdgcn_mfma_f32_32x32x16_bf16(PAF(3),VFR(7),o[1],0,0,0), C1,12); \
    }while(0)
  int t=1;
  for(;t+5<NT;t+=2){
    STEP(pB0,pB1,pA0,pA1,t,true,true,true);     WAIT_BAR(2); RESC(); ROT();
    STEP(pA0,pA1,pB0,pB1,t+1,true,true,true);   WAIT_BAR(2); RESC(); ROT();
  }
  #define ENDW(tt) do{ if((tt)+3<NT){WAIT_BAR(2);} else if((tt)+2<NT){WAIT_BAR(1);} else {WAIT_BAR(0);} }while(0)
  for(;t+1<NT;t+=2){
    STEP(pB0,pB1,pA0,pA1,t,(t+3<NT),(t+1<NT),(t+1<NT));       ENDW(t);   RESC(); ROT();
    STEP(pA0,pA1,pB0,pB1,t+1,(t+4<NT),(t+2<NT),(t+2<NT));     ENDW(t+1); RESC(); ROT();
  }
  STEP(pB0,pB1,pA0,pA1,NT-1,false,false,false); RESC();
  { float sacc=pB0[0]+pB0[1]; _Pragma("unroll") for(int r=2;r<16;++r)sacc+=pB0[r]; _Pragma("unroll") for(int r=0;r<16;++r)sacc+=pB1[r]; l_reg+=sacc;
    pw0=(u32x4){PKW(pB0,0),PKW(pB0,2),PKW(pB0,4),PKW(pB0,6)};pw1=(u32x4){PKW(pB0,8),PKW(pB0,10),PKW(pB0,12),PKW(pB0,14)};pw2=(u32x4){PKW(pB1,0),PKW(pB1,2),PKW(pB1,4),PKW(pB1,6)};pw3=(u32x4){PKW(pB1,8),PKW(pB1,10),PKW(pB1,12),PKW(pB1,14)};
    SBAR(); pv(o,vb0+sl_cur,PAF(0),PAF(1),PAF(2),PAF(3)); }
  #undef PKW
  #undef PAF
  #undef VFR
  #undef PIN
  #undef MX3
  #undef GAPA
  #undef GAPB
  #undef EX
  #undef VRD
  #undef KRD
  #undef STEP
  #undef ENDW
  {auto rr=__builtin_amdgcn_permlane32_swap(__float_as_uint(l_reg),__float_as_uint(l_reg),false,false);l_reg=__uint_as_float(rr[0])+__uint_as_float(rr[1]);}
  if(hi==0)wsf[32+r32]=l_reg;asm volatile("s_waitcnt lgkmcnt(0)":::"memory");
  float rli[16];
  #pragma unroll
  for(int r=0;r<16;++r)rli[r]=__builtin_amdgcn_rcpf(wsf[32+crow(r,hi)]);
  bf16*Ow=J.O+(long)(wid*QBLK)*op;
  { bf16*stg=(bf16*)(shm+LDS_OST)+wid*2048;
    #pragma unroll
    for(int r=0;r<16;++r){const int orow=crow(r,hi);
      #pragma unroll
      for(int d0=0;d0<2;++d0)stg[orow*64+d0*32+r32]=__float2bfloat16(o[d0][r]*rli[r]);}
    asm volatile("s_waitcnt lgkmcnt(0)":::"memory");
    #pragma unroll
    for(int i=0;i<4;++i){const int row=i*8+(lane>>3),ch=lane&7; const u32x4 v=*(const u32x4*)(stg+row*64+ch*8); ATTN_STORE16(Ow+(long)row*op+ch*8,v);} }
  asm volatile("s_waitcnt lgkmcnt(0)\n\ts_barrier":::"memory");
  #undef DMA_K
  #undef DMA_V
  #undef TROW
  #undef CMASK
  #undef BTKIND
  #undef DMA_BT
  #undef BT_READ
  #undef START
  #undef RESC
  #undef ROT
}
#undef SBAR
#undef WAIT_BAR
}

constexpr int NWAVES = 8;
constexpr int D = 1024, NB = 32, SEQ = 2048, CTXL = 256, TPB = SEQ + CTXL, M = NB * TPB, NPAN = M / 256, MLAT = NB * SEQ;
constexpr int DFF = 2816, DFE = 3584, NEXP = 8;
constexpr float EPSN = 1e-6f, LOG2E = 1.4426950408889634f, C2 = 0.125f * LOG2E;
constexpr int NPH = 22;

constexpr size_t MiB = 1u << 20;
constexpr size_t WS_CTL = 0, CTL_ZERO_BYTES = 1 * MiB;
constexpr size_t WS_MOD = 1 * MiB;
constexpr size_t WS_ROPE = 3 * MiB;
constexpr size_t WS_TKE = 4 * MiB;
constexpr size_t WS_TKR = WS_TKE + 512 * 1024;
constexpr size_t WS_TKW = WS_TKR + 512 * 1024;
constexpr size_t WS_STOK = WS_TKW + 512 * 1024;
constexpr size_t WS_SW = WS_STOK + 640 * 1024;
constexpr size_t WS_L16 = WS_SW + 640 * 1024;
constexpr size_t WS_WFT = 8 * MiB, WS_WQKVE = 10 * MiB, WS_WOE = 13 * MiB, WS_W13E = 15 * MiB, WS_W2E = 26 * MiB, WS_WINO = 32 * MiB, WS_WOO = 35 * MiB,
                 WS_GLUW = 37 * MiB, WS_PST = 38 * MiB, WS_MQT = 40 * MiB, WS_D256L = 44 * MiB, WS_D256C = WS_D256L + 512 * 1024, WS_FC = WS_D256L + 1024 * 1024, WS_TWD = WS_D256L + 1536 * 1024, WS_EW13 = 61 * MiB, WS_EW2 = 173 * MiB;
constexpr size_t WS_XC = 229 * MiB, WS_HN = 261 * MiB, WS_R = 405 * MiB;
constexpr size_t WS_H1 = WS_R, WS_OE = WS_R + 216 * MiB, WS_TT = WS_R + 360 * MiB, WS_UTC = WS_R + 440 * MiB, WS_UTL = WS_R + 448 * MiB, WS_VT = WS_R + 448 * MiB;
constexpr size_t WS_O = WS_R + 360 * MiB;
constexpr size_t WS_HMID = WS_R;
constexpr size_t WS_AB = WS_R + 180 * MiB, WS_S = WS_R + 252 * MiB, WS_Z = WS_R + 324 * MiB;
constexpr size_t WS_HNG = WS_R, WS_HME = WS_R + 132 * MiB;
constexpr size_t WS_BTG = 999 * MiB;
constexpr size_t WS_END = 1002 * MiB;
static_assert(WS_VT + 144 * MiB <= WS_END && WS_L16 + 16384 <= WS_WFT && WS_EW2 + 56 * MiB <= WS_XC && WS_O + 144 * MiB <= WS_END && WS_HME + 462 * MiB <= WS_END, "ws map");
constexpr int H1E_P = 1536, H1O_P = 1280;
constexpr int MAXSLOT = 135168;
constexpr int CW_TMO = 0, CW_BAR = 4096, CW_MOE = 200000  , CW_PEXP = 210000  , CW_CHUNK = 212000  , CW_FLAG = 214000  , CW_MFIX = 233000  ;

constexpr int RING_OFF = 0, RING_BYTES = 131072;
constexpr int LDSCTL_OFF = 154112, MISC_OFF = LDSCTL_OFF + 320;
constexpr int LDS_BYTES = 163840;

#define GAS __attribute__((address_space(1)))
#define LAS __attribute__((address_space(3)))
typedef unsigned short bf16;
typedef unsigned v4u __attribute__((ext_vector_type(4)));
typedef unsigned v2u __attribute__((ext_vector_type(2)));
typedef float f32x4 __attribute__((ext_vector_type(4)));
typedef float f32x2 __attribute__((ext_vector_type(2)));
typedef GAS unsigned gu32;
#define RLX_AGENT __ATOMIC_RELAXED, __HIP_MEMORY_SCOPE_AGENT
#define LDS_WAIT() asm volatile("s_waitcnt lgkmcnt(0)" ::: "memory")
#define VM_WAIT() asm volatile("s_waitcnt vmcnt(0)" ::: "memory")
__device__ __forceinline__ unsigned f2bf(float f) { unsigned u = __builtin_bit_cast(unsigned, f); return (u + 0x7fffu + ((u >> 16) & 1u)) >> 16; }
__device__ __forceinline__ unsigned pk2(float lo, float hi) { return f2bf(lo) | (f2bf(hi) << 16); }
__device__ __forceinline__ float bflo(unsigned w) { return __uint_as_float(w << 16); }
__device__ __forceinline__ float bfhi(unsigned w) { return __uint_as_float(w & 0xffff0000u); }
__device__ __forceinline__ f32x4 bf4_to_f32(v2u w) { f32x4 r; r.x = bflo(w.x); r.y = bfhi(w.x); r.z = bflo(w.y); r.w = bfhi(w.y); return r; }
__device__ __forceinline__ float fast_exp(float x) { return __builtin_amdgcn_exp2f(x * LOG2E); }
__device__ __forceinline__ float sigmoidf_(float x) { return __builtin_amdgcn_rcpf(1.0f + fast_exp(-x)); }
__device__ __forceinline__ float siluf_(float x) { return x * sigmoidf_(x); }
__device__ __forceinline__ unsigned pk4_fp8(float a, float b, float c, float d);
__device__ __forceinline__ float gelu_tanh(float x) { const float u = 0.7978845608028654f * (x + 0.044715f * x * x * x); return x * sigmoidf_(2.0f * u); }

#define XB_TMO      128
#define XB_XCNT(j)  (256  + 64 * (j))
#define XB_XSUB(j)  (1280 + 64 * (j))
#define XB_XGEN(j)  (2304 + 64 * (j))
#define XB_TOP      3328
#define XB_TOPGEN   3392
#define XCD_BAR_WORDS 3456
#define XB_SPIN_CAP (1u << 18)
__device__ __forceinline__ unsigned xb_ld(unsigned* p)              { return __hip_atomic_load(p, __ATOMIC_RELAXED, __HIP_MEMORY_SCOPE_AGENT); }
__device__ __forceinline__ unsigned xb_add(unsigned* p, unsigned v) { return __hip_atomic_fetch_add(p, v, __ATOMIC_RELAXED, __HIP_MEMORY_SCOPE_AGENT); }
__device__ __forceinline__ unsigned xb_xcc_id() { return (unsigned)__builtin_amdgcn_s_getreg((3 << 11) | 20) & 0xFu; }
#define XB_SPIN(cond, bar) do { unsigned _sp = 0; while (cond) { __builtin_amdgcn_s_sleep(1); \
    if ((++_sp & 255u) == 0u) { if (xb_ld(&(bar)[XB_TMO])) break; if (_sp > XB_SPIN_CAP) { atomicAdd(&(bar)[XB_TMO], 1u); break; } } } } while (0)
struct XcdBarrier { unsigned* bar; unsigned x; volatile LAS unsigned* st; };
__device__ __forceinline__ XcdBarrier xcd_barrier_post(unsigned* bar, volatile LAS unsigned* st) {
    XcdBarrier b; b.bar = bar; b.x = xb_xcc_id(); b.st = st;
    if (threadIdx.x == 0) (void)xb_add(&bar[XB_XCNT(b.x)], 1u);
    return b;
}
__device__ __forceinline__ void xcd_barrier_complete(unsigned* bar, unsigned x, unsigned& nloc, unsigned& nx) {
    const unsigned G = gridDim.x * gridDim.y * gridDim.z;
    unsigned sum, cnt, mine, sp = 0u;
    for (;;) {
        sum = 0u; cnt = 0u; mine = 0u;
#pragma unroll
        for (unsigned j = 0; j < 16; ++j) { const unsigned c = xb_ld(&bar[XB_XCNT(j)]); sum += c; cnt += (c > 0u) ? 1u : 0u; mine = (j == x) ? c : mine; }
        if (sum == G) break;
        __builtin_amdgcn_s_sleep(1);
        if ((++sp & 255u) == 0u) { if (xb_ld(&bar[XB_TMO])) break; if (sp > XB_SPIN_CAP) { atomicAdd(&bar[XB_TMO], 1u); break; } }
    }
    nloc = mine > 0u ? mine : 1u; nx = cnt > 0u ? cnt : 1u;
}
__device__ __forceinline__ void xcd_barrier(const XcdBarrier& b) {
    asm volatile("s_waitcnt vmcnt(0)" ::: "memory");
    __syncthreads();
    if (threadIdx.x == 0) {
        unsigned* bar = b.bar;
        __builtin_amdgcn_s_waitcnt(0);
        unsigned nloc = b.st[0], nx = b.st[1];
        if (nloc == 0u) { xcd_barrier_complete(bar, b.x, nloc, nx); b.st[0] = nloc; b.st[1] = nx; }
        const unsigned old = xb_add(&bar[XB_XSUB(b.x)], 1u);
        const unsigned gen = old / nloc;
        if (old + 1u == (gen + 1u) * nloc) {
            __builtin_amdgcn_fence(__ATOMIC_RELEASE, "agent");
            asm volatile("s_waitcnt vmcnt(0)" ::: "memory");
            const unsigned og = xb_add(&bar[XB_TOP], 1u);
            const unsigned tg = og / nx;
            if (og + 1u == (tg + 1u) * nx) xb_add(&bar[XB_TOPGEN], 1u);
            else XB_SPIN(xb_ld(&bar[XB_TOPGEN]) == tg, bar);
            __builtin_amdgcn_fence(__ATOMIC_ACQUIRE, "agent");
            xb_add(&bar[XB_XGEN(b.x)], 1u);
            asm volatile("s_waitcnt vmcnt(0)" ::: "memory");
        } else {
            XB_SPIN(xb_ld(&bar[XB_XGEN(b.x)]) == gen, bar);
            __builtin_amdgcn_fence(__ATOMIC_ACQUIRE, "agent");
            asm volatile("s_waitcnt vmcnt(0)" ::: "memory");
        }
    }
    __syncthreads();
}

struct Frame {
    LAS unsigned char* lds;
    volatile LAS unsigned* MISC;
    unsigned* ctl;
    int tid, lane, wave, vcu, G;
    const float* const* in;
    unsigned char* ws;
    bf16* XL; bf16* XC; float* OUT; bf16* X3P;
};
__device__ __forceinline__ float wave_sum(float v) {
#pragma unroll
    for (int o = 1; o < 64; o <<= 1) v += __shfl_xor(v, o);
    return v;
}
template <class T> __device__ __forceinline__ T* wsp(const Frame& F, size_t off) { return (T*)(F.ws + off); }
__device__ __forceinline__ float attn_mfix(const float* qg, const float* kg, const float* rpb, int nrpb, int lane) {
    float a = fabsf(qg[lane]), b = fabsf(kg[lane]), c = 0.f;
    for (int i = lane; i < nrpb; i += 64) c = fmaxf(c, fabsf(rpb[i]));
#pragma unroll
    for (int o = 1; o < 64; o <<= 1) { a = fmaxf(a, __shfl_xor(a, o)); b = fmaxf(b, __shfl_xor(b, o)); c = fmaxf(c, __shfl_xor(c, o)); }
    return __int_as_float(__builtin_amdgcn_readfirstlane(__float_as_int((8.0f * 1.03f * a * b + c) * LOG2E + 0.01f)));
}
__device__ __forceinline__ const float* modp(const Frame& F, int layer, int bidx, int chunk) { return wsp<const float>(F, WS_MOD) + ((size_t)(layer * 33 + bidx) * 6 + chunk) * 1024; }

using pg8::Unit; using pg8::cvt_pk_bf16;
typedef pg8::f32x4 (&AccRef)[2][2][4][2];
#define EPI_FOR_ROWS _Pragma("unroll") for (int ai = 0; ai < 2; ++ai) _Pragma("unroll") for (int m = 0; m < 4; ++m)

struct EpiPlainBf16 {
    static constexpr bool PERM = true;
    bf16* O; int ldc, zrows, rowoff, zcols;
    __device__ __forceinline__ void operator()(const pg8::f32x4 (&acc)[2][2][4][2], const Unit& u, int wr, int wc, int fr, int fq) const {
        const size_t row0 = (size_t)u.z * zrows + rowoff + u.pm * 256 + wr * 64 + fr; const int col0 = u.z * zcols + u.pn * 256 + wc * 32 + 8 * fq;
        EPI_FOR_ROWS { bf16* rowp = O + (row0 + ai * 128 + m * 16) * ldc + col0;
#pragma unroll
            for (int bj = 0; bj < 2; ++bj) { const pg8::f32x4 v0 = acc[ai][bj][m][0], v1 = acc[ai][bj][m][1];
                v4u w; w.x = cvt_pk_bf16(v0[0], v0[1]); w.y = cvt_pk_bf16(v0[2], v0[3]); w.z = cvt_pk_bf16(v1[0], v1[1]); w.w = cvt_pk_bf16(v1[2], v1[3]);
                *(v4u*)(rowp + bj * 128) = w; } }
    }
};
struct EpiFourT {
    static constexpr bool PERM = true;
    bf16* UTL; bf16* UTC;
    __device__ __forceinline__ void operator()(const pg8::f32x4 (&acc)[2][2][4][2], const Unit& u, int wr, int wc, int fr, int fq) const {
        const int b = u.pn / 9, tp = u.pn % 9; const int col0 = wc * 32 + 8 * fq;
        EPI_FOR_ROWS { const int ch = u.pm * 256 + ai * 128 + wr * 64 + m * 16 + fr;
            bf16* rowp = (tp == 0) ? UTC + ((size_t)(b * 512 + ch) * 256 + col0) : UTL + ((size_t)(b * 512 + ch) * 2048 + (tp - 1) * 256 + col0);
#pragma unroll
            for (int bj = 0; bj < 2; ++bj) { const pg8::f32x4 v0 = acc[ai][bj][m][0], v1 = acc[ai][bj][m][1];
                v4u w; w.x = cvt_pk_bf16(v0[0], v0[1]); w.y = cvt_pk_bf16(v0[2], v0[3]); w.z = cvt_pk_bf16(v1[0], v1[1]); w.w = cvt_pk_bf16(v1[2], v1[3]);
                *(v4u*)(rowp + bj * 128) = w; } }
    }
};
struct EpiVT {
    static constexpr bool PERM = true;
    bf16* VT; int lat;
    __device__ __forceinline__ void operator()(const pg8::f32x4 (&acc)[2][2][4][2], const Unit& u, int wr, int wc, int fr_, int fq_) const {
        int tl = threadIdx.x; asm volatile("" : "+v"(tl)); const int fr = tl & 15, fq = (tl >> 4) & 3;
        const int b = lat ? u.z / 5 : u.z, k1 = lat ? u.z % 5 : 0, kstr = lat ? 8 : 1, ri = u.pm; const size_t rowbase = (size_t)b * TPB + (lat ? CTXL : 0);
        const bool mir = lat && k1 >= 1 && k1 <= 3; const unsigned sgn = ri ? 0x80008000u : 0u;
        const int cbase = u.pn * 512 + ri * 128 + wc * 32 + 8 * fq;
        EPI_FOR_ROWS { const int k2 = ai * 128 + wr * 64 + m * 16 + fr; bf16* rowp = VT + (rowbase + k1 + kstr * k2) * 1024 + cbase;
#pragma unroll
            for (int bj = 0; bj < 2; ++bj) { const pg8::f32x4 v0 = acc[ai][bj][m][0], v1 = acc[ai][bj][m][1];
                v4u w; w.x = cvt_pk_bf16(v0[0], v0[1]); w.y = cvt_pk_bf16(v0[2], v0[3]); w.z = cvt_pk_bf16(v1[0], v1[1]); w.w = cvt_pk_bf16(v1[2], v1[3]);
                *(v4u*)(rowp + bj * 256) = w; }
            asm volatile("" ::: "memory"); }
        if (mir) { EPI_FOR_ROWS { const int k2 = ai * 128 + wr * 64 + m * 16 + fr; bf16* rowp = VT + (rowbase + (8 - k1) + 8 * (255 - k2)) * 1024 + cbase;
#pragma unroll
            for (int bj = 0; bj < 2; ++bj) { const pg8::f32x4 v0 = acc[ai][bj][m][0], v1 = acc[ai][bj][m][1];
                v4u w; w.x = cvt_pk_bf16(v0[0], v0[1]) ^ sgn; w.y = cvt_pk_bf16(v0[2], v0[3]) ^ sgn; w.z = cvt_pk_bf16(v1[0], v1[1]) ^ sgn; w.w = cvt_pk_bf16(v1[2], v1[3]) ^ sgn;
                *(v4u*)(rowp + bj * 256) = w; }
            asm volatile("" ::: "memory"); } }
    }
};
struct EpiOddIn {
    static constexpr bool PERM = true;
    bf16* H1; bf16* AB;
    __device__ __forceinline__ void operator()(const pg8::f32x4 (&acc)[2][2][4][2], const Unit& u, int wr, int wc, int fr, int fq) const {
        const int row0 = u.pm * 256 + wr * 64 + fr, cl0 = wc * 32 + 8 * fq;
        EPI_FOR_ROWS { const int row = row0 + ai * 128 + m * 16;
#pragma unroll
            for (int bj = 0; bj < 2; ++bj) { const pg8::f32x4 v0 = acc[ai][bj][m][0], v1 = acc[ai][bj][m][1];
                v4u w; w.x = cvt_pk_bf16(v0[0], v0[1]); w.y = cvt_pk_bf16(v0[2], v0[3]); w.z = cvt_pk_bf16(v1[0], v1[1]); w.w = cvt_pk_bf16(v1[2], v1[3]);
                const int cl = cl0 + bj * 128;
                if (u.pn < 5) *(v4u*)(H1 + (size_t)row * H1O_P + u.pn * 256 + cl) = w;
                else { const int g = cl >> 4, n0 = cl & 15; *(v4u*)(AB + ((size_t)(g * 4608 + (row >> 4)) * 512 + (row & 15) * 16 + n0)) = w; } } }
    }
};
template <bool ODD> struct EpiQKV {
    static constexpr bool PERM = true;
    bf16* H1; bf16* AB; const float* qg; const float* kg; const float* rc; const float* rs; LAS float* xch; float s; int pn0;
    __device__ __forceinline__ void operator()(const pg8::f32x4 (&acc)[2][2][4][2], const Unit& u, int wr, int wc, int fr_, int fq_) const {
        int tl = threadIdx.x; asm volatile("" : "+v"(tl)); const int fr = tl & 15, fq = (tl >> 4) & 3; const int wid = wr * 4 + wc;
        constexpr int P = ODD ? H1O_P : H1E_P;
        const int row0 = u.pm * 256 + wr * 64 + fr, cl0 = wc * 32 + 8 * fq;
        const int upn = u.pn + pn0;
        const bool normtile = ODD ? (upn <= 3) : (upn <= 3);
        if (!normtile) {
            EPI_FOR_ROWS { const int row = row0 + ai * 128 + m * 16;
#pragma unroll
                for (int bj = 0; bj < 2; ++bj) { const pg8::f32x4 v0 = acc[ai][bj][m][0] * s, v1 = acc[ai][bj][m][1] * s;
                    v4u w; w.x = cvt_pk_bf16(v0[0], v0[1]); w.y = cvt_pk_bf16(v0[2], v0[3]); w.z = cvt_pk_bf16(v1[0], v1[1]); w.w = cvt_pk_bf16(v1[2], v1[3]);
                    const int cl = cl0 + bj * 128;
                    if (!ODD || upn < 5) *(v4u*)(H1 + (size_t)row * P + upn * 256 + cl) = w;
                    else { const int g = cl >> 4, n0 = cl & 15; *(v4u*)(AB + ((size_t)(g * 4608 + (row >> 4)) * 512 + (row & 15) * 16 + n0)) = w; } } }
            return; }
        float ss[2][4][2];
        EPI_FOR_ROWS {
#pragma unroll
            for (int bj = 0; bj < 2; ++bj) { const pg8::f32x4 v0 = acc[ai][bj][m][0] * this->s, v1 = acc[ai][bj][m][1] * this->s;
                float s = (v0[0] * v0[0] + v0[1] * v0[1]) + (v0[2] * v0[2] + v0[3] * v0[3]) + (v1[0] * v1[0] + v1[1] * v1[1]) + (v1[2] * v1[2] + v1[3] * v1[3]);
                s += __shfl_xor(s, 16); s += __shfl_xor(s, 32); ss[ai][m][bj] = s; } }
        if (fq == 0) { EPI_FOR_ROWS {
#pragma unroll
            for (int bj = 0; bj < 2; ++bj) xch[((wid * 8 + ai * 4 + m) * 2 + bj) * 16 + fr] = ss[ai][m][bj]; } }
        asm volatile("s_waitcnt lgkmcnt(0)" ::: "memory"); __builtin_amdgcn_s_barrier(); asm volatile("" ::: "memory");
        EPI_FOR_ROWS {
#pragma unroll
            for (int bj = 0; bj < 2; ++bj) ss[ai][m][bj] += xch[(((wid ^ 1) * 8 + ai * 4 + m) * 2 + bj) * 16 + fr]; }
        const int d0 = (wc & 1) * 32 + 8 * fq;
        const pg8::f32x4 gq0 = *(const pg8::f32x4*)(qg + d0) * C2, gq1 = *(const pg8::f32x4*)(qg + d0 + 4) * C2, gk0 = *(const pg8::f32x4*)(kg + d0), gk1 = *(const pg8::f32x4*)(kg + d0 + 4);
        const int tp = u.pm % 9;
        EPI_FOR_ROWS { const int rl = wr * 64 + fr + ai * 128 + m * 16; const int row = u.pm * 256 + rl;
            pg8::f32x4 c4 = {1.f, 1.f, 1.f, 1.f}, s4 = {0.f, 0.f, 0.f, 0.f};
            if (ODD && tp > 0) { const int n = (tp - 1) * 256 + rl; c4 = *(const pg8::f32x4*)(rc + n * 32 + (d0 >> 1)); s4 = *(const pg8::f32x4*)(rs + n * 32 + (d0 >> 1)); }
#pragma unroll
            for (int bj = 0; bj < 2; ++bj) { const int col = upn * 256 + bj * 128 + (wc >> 1) * 64;
                const int mode = ODD ? (col < 768 ? 0 : (col < 960 ? 1 : 2)) : (upn < 2 ? 0 : 1);
                pg8::f32x4 v0 = acc[ai][bj][m][0] * s, v1 = acc[ai][bj][m][1] * s;
                if (mode < 2) { const float rstd = __builtin_amdgcn_rsqf(ss[ai][m][bj] * (1.0f / 64.0f) + EPSN);
                    v0 = v0 * rstd * (mode == 0 ? gq0 : gk0); v1 = v1 * rstd * (mode == 0 ? gq1 : gk1);
                    if (ODD && tp > 0) { pg8::f32x4 a = v0, b = v1;
                        v0[0] = a[0] * c4[0] - a[1] * s4[0]; v0[1] = a[0] * s4[0] + a[1] * c4[0]; v0[2] = a[2] * c4[1] - a[3] * s4[1]; v0[3] = a[2] * s4[1] + a[3] * c4[1];
                        v1[0] = b[0] * c4[2] - b[1] * s4[2]; v1[1] = b[0] * s4[2] + b[1] * c4[2]; v1[2] = b[2] * c4[3] - b[3] * s4[3]; v1[3] = b[2] * s4[3] + b[3] * c4[3]; } }
                v4u w; w.x = cvt_pk_bf16(v0[0], v0[1]); w.y = cvt_pk_bf16(v0[2], v0[3]); w.z = cvt_pk_bf16(v1[0], v1[1]); w.w = cvt_pk_bf16(v1[2], v1[3]);
                *(v4u*)(H1 + (size_t)row * P + upn * 256 + bj * 128 + cl0) = w; }
            asm volatile("" ::: "memory"); }
    }
};
struct EpiPlainF32 {
    static constexpr bool PERM = false;
    float* C; int ldc, zrows;
    __device__ __forceinline__ void operator()(const pg8::f32x4 (&acc)[2][2][4][2], const Unit& u, int wr, int wc, int fr, int fq) const {
        const size_t row0 = (size_t)u.z * zrows + u.pm * 256 + wr * 64 + fr; const int col0 = u.pn * 256 + wc * 32 + 4 * fq;
        EPI_FOR_ROWS { float* rowp = C + (row0 + ai * 128 + m * 16) * ldc + col0;
#pragma unroll
            for (int bj = 0; bj < 2; ++bj)
#pragma unroll
                for (int n = 0; n < 2; ++n) *(pg8::f32x4*)(rowp + bj * 128 + n * 16) = acc[ai][bj][m][n]; }
    }
};
template <bool INF32> struct EpiResid {
    static constexpr bool PERM = true;
    const void* inL; const void* inC; bf16* outL; bf16* outC; const float* mod; int gchunk;
    __device__ __forceinline__ void operator()(const pg8::f32x4 (&acc)[2][2][4][2], const Unit& u, int wr, int wc, int fr_, int fq_) const {
        int tl = threadIdx.x; asm volatile("" : "+v"(tl)); const int fr = tl & 15, fq = (tl >> 4) & 3;
        const int b = u.pm / 9, tp = u.pm % 9;
        const float* gate = mod + ((size_t)(tp == 0 ? 32 : b) * 6 + gchunk) * 1024;
        const int col0 = u.pn * 256 + wc * 32 + 8 * fq;
        pg8::f32x4 gv[2][2];
#pragma unroll
        for (int bj = 0; bj < 2; ++bj)
#pragma unroll
            for (int n = 0; n < 2; ++n) gv[bj][n] = *(const pg8::f32x4*)(gate + col0 + bj * 128 + n * 4);
        const size_t rbase = (tp == 0) ? (size_t)(b * 256) * D : (size_t)(b * 2048 + (tp - 1) * 256) * D;
        const void* inp = (tp == 0) ? inC : inL; bf16* out = ((tp == 0) ? outC : outL) + rbase;
        const size_t off0 = (size_t)(wr * 64 + fr) * D + col0;
#pragma unroll
        for (int ai = 0; ai < 2; ++ai) {
            if (INF32) { pg8::f32x4 xin[4][2][2];
#pragma unroll
                for (int m = 0; m < 4; ++m)
#pragma unroll
                    for (int bj = 0; bj < 2; ++bj) { const float* in = (const float*)inp + rbase + off0 + (size_t)(ai * 128 + m * 16) * D + bj * 128; xin[m][bj][0] = *(const pg8::f32x4*)in; xin[m][bj][1] = *(const pg8::f32x4*)(in + 4); }
#pragma unroll
                for (int m = 0; m < 4; ++m)
#pragma unroll
                    for (int bj = 0; bj < 2; ++bj) { const pg8::f32x4 y0 = xin[m][bj][0] + gv[bj][0] * acc[ai][bj][m][0], y1 = xin[m][bj][1] + gv[bj][1] * acc[ai][bj][m][1];
                        v4u o; o.x = cvt_pk_bf16(y0[0], y0[1]); o.y = cvt_pk_bf16(y0[2], y0[3]); o.z = cvt_pk_bf16(y1[0], y1[1]); o.w = cvt_pk_bf16(y1[2], y1[3]);
                        *(v4u*)(out + off0 + (size_t)(ai * 128 + m * 16) * D + bj * 128) = o; }
            } else { v4u xin[4][2];
#pragma unroll
                for (int m = 0; m < 4; ++m)
#pragma unroll
                    for (int bj = 0; bj < 2; ++bj) xin[m][bj] = *(const v4u*)((const bf16*)inp + rbase + off0 + (size_t)(ai * 128 + m * 16) * D + bj * 128);
#pragma unroll
                for (int m = 0; m < 4; ++m)
#pragma unroll
                    for (int bj = 0; bj < 2; ++bj) { const v4u w = xin[m][bj];
                        const pg8::f32x4 x0 = (pg8::f32x4){bflo(w.x), bfhi(w.x), bflo(w.y), bfhi(w.y)}, x1 = (pg8::f32x4){bflo(w.z), bfhi(w.z), bflo(w.w), bfhi(w.w)};
                        const pg8::f32x4 y0 = x0 + gv[bj][0] * acc[ai][bj][m][0], y1 = x1 + gv[bj][1] * acc[ai][bj][m][1];
                        v4u o; o.x = cvt_pk_bf16(y0[0], y0[1]); o.y = cvt_pk_bf16(y0[2], y0[3]); o.z = cvt_pk_bf16(y1[0], y1[1]); o.w = cvt_pk_bf16(y1[2], y1[3]);
                        *(v4u*)(out + off0 + (size_t)(ai * 128 + m * 16) * D + bj * 128) = o; }
            }
            asm volatile("" ::: "memory"); }
    }
};
__device__ __forceinline__ unsigned pk4_fp8(float a, float b, float c, float d) {
    a = __builtin_amdgcn_fmed3f(a, -448.f, 448.f); b = __builtin_amdgcn_fmed3f(b, -448.f, 448.f); c = __builtin_amdgcn_fmed3f(c, -448.f, 448.f); d = __builtin_amdgcn_fmed3f(d, -448.f, 448.f);
    int w = 0; w = __builtin_amdgcn_cvt_pk_fp8_f32(a, b, w, false); w = __builtin_amdgcn_cvt_pk_fp8_f32(c, d, w, true); return (unsigned)w; }
template <bool F8> struct EpiSwiglu {
    static constexpr bool PERM = true;
    unsigned char* H; int ldh, local; float sa, sb;
    __device__ __forceinline__ void operator()(const pg8::f32x4 (&acc)[2][2][4][2], const Unit& u, int wr, int wc, int fr_, int fq_) const {
        int tl = threadIdx.x; asm volatile("" : "+v"(tl)); const int fr = tl & 15, fq = (tl >> 4) & 3;
        const size_t row0 = (size_t)(local ? u.aux : u.pm) * 256 + wr * 64 + fr; const int h0 = u.pn * 128 + wc * 32 + 8 * fq;
        typedef float f32x2_ __attribute__((ext_vector_type(2)));
        const float kx = -sa * LOG2E, ic = 1.0f / (sa * sb); const f32x2_ kexp = {kx, kx}, invc = {ic, ic};
        EPI_FOR_ROWS { float o[8];
#pragma unroll
            for (int n = 0; n < 2; ++n)
#pragma unroll
                for (int e = 0; e < 4; e += 2) { const f32x2_ a = {acc[ai][0][m][n][e], acc[ai][0][m][n][e + 1]}, b = {acc[ai][1][m][n][e], acc[ai][1][m][n][e + 1]};
                    const f32x2_ t = a * kexp; f32x2_ ex; ex.x = __builtin_amdgcn_exp2f(t.x); ex.y = __builtin_amdgcn_exp2f(t.y);
                    const f32x2_ d = ex * invc + invc; f32x2_ r; r.x = __builtin_amdgcn_rcpf(d.x); r.y = __builtin_amdgcn_rcpf(d.y);
                    const f32x2_ q = (a * b) * r; o[4 * n + e] = q.x; o[4 * n + e + 1] = q.y; }
            if (F8) { v2u w; w.x = pk4_fp8(o[0], o[1], o[2], o[3]); w.y = pk4_fp8(o[4], o[5], o[6], o[7]); __builtin_nontemporal_store(w, (v2u*)(H + (row0 + ai * 128 + m * 16) * ldh + h0)); }
            else { v4u w; w.x = cvt_pk_bf16(o[0], o[1]); w.y = cvt_pk_bf16(o[2], o[3]); w.z = cvt_pk_bf16(o[4], o[5]); w.w = cvt_pk_bf16(o[6], o[7]); __builtin_nontemporal_store(w, (v4u*)((bf16*)H + (row0 + ai * 128 + m * 16) * ldh + h0)); } }
    }
};
struct EpiS5B {
    static constexpr bool PERM = true;
    const bf16* AB; const float* dsk; bf16* Z;
    __device__ __forceinline__ void operator()(const pg8::f32x4 (&acc)[2][2][4][2], const Unit& u, int wr, int wc, int fr, int fq) const {
        const int g = u.z, cl0 = wc * 32 + 8 * fq;
        EPI_FOR_ROWS { const int cr = u.pm * 256 + ai * 128 + wr * 64 + m * 16 + fr, b = cr / 144, c = cr % 144;
            if (c >= 16) {
#pragma unroll
                for (int bj = 0; bj < 2; ++bj) { const int cl = cl0 + bj * 128, i = cl >> 4, m0 = cl & 15;
                    const v4u uu = *(const v4u*)(AB + ((size_t)(g * 4608 + cr) * 512 + cl));
                    const pg8::f32x4 d0 = *(const pg8::f32x4*)(dsk + g * 16 + m0), d1 = *(const pg8::f32x4*)(dsk + g * 16 + m0 + 4);
                    const pg8::f32x4 v0 = acc[ai][bj][m][0], v1 = acc[ai][bj][m][1];
                    float y[8];
                    y[0] = v0[0] + d0[0] * bflo(uu.x); y[1] = v0[1] + d0[1] * bfhi(uu.x); y[2] = v0[2] + d0[2] * bflo(uu.y); y[3] = v0[3] + d0[3] * bfhi(uu.y);
                    y[4] = v1[0] + d1[0] * bflo(uu.z); y[5] = v1[1] + d1[1] * bfhi(uu.z); y[6] = v1[2] + d1[2] * bflo(uu.w); y[7] = v1[3] + d1[3] * bfhi(uu.w);
#pragma unroll
                    for (int e = 0; e < 8; ++e) y[e] = gelu_tanh(y[e]);
                    v4u w; w.x = cvt_pk_bf16(y[0], y[1]); w.y = cvt_pk_bf16(y[2], y[3]); w.z = cvt_pk_bf16(y[4], y[5]); w.w = cvt_pk_bf16(y[6], y[7]);
                    *(v4u*)(Z + ((size_t)(b * TPB + 16 * c + i) * 256 + g * 16 + m0)) = w; } }
            asm volatile("" ::: "memory"); }
    }
};
struct EpiGLU {
    static constexpr bool PERM = true;
    const bf16* Z; const float* bias; bf16* O;
    __device__ __forceinline__ void operator()(const pg8::f32x4 (&acc)[2][2][4][2], const Unit& u, int wr, int wc, int fr, int fq) const {
        const int row0 = u.pm * 256 + wr * 64 + fr, cl0 = wc * 32 + 8 * fq;
        EPI_FOR_ROWS { const size_t row = (size_t)(row0 + ai * 128 + m * 16);
#pragma unroll
            for (int bj = 0; bj < 2; ++bj) { const int cl = cl0 + bj * 128;
                const v4u zz = *(const v4u*)(Z + row * 256 + cl);
                const pg8::f32x4 b0 = *(const pg8::f32x4*)(bias + cl), b1 = *(const pg8::f32x4*)(bias + cl + 4);
                const pg8::f32x4 v0 = acc[ai][bj][m][0] + b0, v1 = acc[ai][bj][m][1] + b1;
                v4u w; w.x = cvt_pk_bf16(bflo(zz.x) * sigmoidf_(v0[0]), bfhi(zz.x) * sigmoidf_(v0[1])); w.y = cvt_pk_bf16(bflo(zz.y) * sigmoidf_(v0[2]), bfhi(zz.y) * sigmoidf_(v0[3]));
                w.z = cvt_pk_bf16(bflo(zz.z) * sigmoidf_(v1[0]), bfhi(zz.z) * sigmoidf_(v1[1])); w.w = cvt_pk_bf16(bflo(zz.w) * sigmoidf_(v1[2]), bfhi(zz.w) * sigmoidf_(v1[3]));
                *(v4u*)(O + row * 1024 + 768 + cl) = w; }
            asm volatile("" ::: "memory"); }
    }
};
template <bool LASTH> struct EpiMoe2 {
    static constexpr bool PERM = true;
    const bf16* Xin; void* Xout; const int* stok; const float* sw; const float* mod;
    __device__ __forceinline__ void operator()(const pg8::f32x4 (&acc)[2][2][4][2], const Unit& u, int wr, int wc, int fr_, int fq_) const {
        int tl = threadIdx.x; asm volatile("" : "+v"(tl)); const int fr = tl & 15, fq = (tl >> 4) & 3;
        const int slot0 = u.pm * 256 + wr * 64 + fr, col0 = u.pn * 256 + wc * 32 + 8 * fq;
        int tok[2][4]; float wv[2][4];
        EPI_FOR_ROWS { const int slot = slot0 + ai * 128 + m * 16; tok[ai][m] = stok[slot]; wv[ai][m] = sw[slot] * (1.0f / 512.0f);   }
#pragma unroll
        for (int ai = 0; ai < 2; ++ai)
#pragma unroll
            for (int bj = 0; bj < 2; ++bj) { v4u xw[4]; pg8::f32x4 g0[4], g1[4];
#pragma unroll
                for (int m = 0; m < 4; ++m) { const int t = tok[ai][m] < 0 ? 0 : tok[ai][m]; const float* gate = mod + ((size_t)(t >> 11) * 6 + 5) * 1024 + col0 + bj * 128;
                    xw[m] = *(const v4u*)(Xin + (size_t)t * D + col0 + bj * 128); g0[m] = *(const pg8::f32x4*)gate; g1[m] = *(const pg8::f32x4*)(gate + 4); }
#pragma unroll
                for (int m = 0; m < 4; ++m) { if (tok[ai][m] >= 0) { const float w = wv[ai][m]; const size_t xo = (size_t)tok[ai][m] * D + col0 + bj * 128;
                    const pg8::f32x4 x0 = (pg8::f32x4){bflo(xw[m].x), bfhi(xw[m].x), bflo(xw[m].y), bfhi(xw[m].y)}, x1 = (pg8::f32x4){bflo(xw[m].z), bfhi(xw[m].z), bflo(xw[m].w), bfhi(xw[m].w)};
                    const pg8::f32x4 y0 = x0 + (g0[m] * w) * acc[ai][bj][m][0], y1 = x1 + (g1[m] * w) * acc[ai][bj][m][1];
                    if (LASTH) { float* o = (float*)Xout + xo; *(pg8::f32x4*)o = y0; *(pg8::f32x4*)(o + 4) = y1; }
                    else { v4u o; o.x = cvt_pk_bf16(y0[0], y0[1]); o.y = cvt_pk_bf16(y0[2], y0[3]); o.z = cvt_pk_bf16(y1[0], y1[1]); o.w = cvt_pk_bf16(y1[2], y1[3]); *(v4u*)((bf16*)Xout + xo) = o; } } }
                asm volatile("" ::: "memory"); }
    }
};

template <int MAP> __device__ __forceinline__ int map_row(int n) { return MAP == 0 ? n : (MAP == 1 ? (((n >> 7) << 8) + (n & 127)) : (((n >> 7) << 8) + 128 + (n & 127))); }
template <int MAP> __device__ __forceinline__ void tr_item(const float* W, int ldw, int col0, int K, int nblk, bf16* WT, int row_off, LAS float* scr, int item, int lane) {
    const int kb = item / nblk, nb = item % nblk, k0 = 64 * kb, n0 = 32 * nb;
#pragma unroll 8
    for (int i = 0; i < 32; ++i) { const int kk = 2 * i + (lane >> 5); scr[kk * 33 + (lane & 31)] = W[(size_t)(k0 + kk) * ldw + col0 + n0 + (lane & 31)]; }
    LDS_WAIT(); asm volatile("" ::: "memory");
    const int c = lane & 7;
#pragma unroll
    for (int j = 0; j < 4; ++j) { const int n = (lane >> 3) + 8 * j; const LAS float* s = scr + (8 * c) * 33 + n;
        v4u o; o.x = pk2(s[0 * 33], s[1 * 33]); o.y = pk2(s[2 * 33], s[3 * 33]); o.z = pk2(s[4 * 33], s[5 * 33]); o.w = pk2(s[6 * 33], s[7 * 33]);
        *(GAS v4u*)(WT + (size_t)(row_off + map_row<MAP>(n0 + n)) * K + k0 + 8 * c) = o; }
    LDS_WAIT(); asm volatile("" ::: "memory");
}
template <int MAP> __device__ __forceinline__ void tr_item_f8(const float* W, int ldw, int K, int nblk, unsigned char* WT, float scale, LAS float* scr, int item, int lane) {
    const int kb = item / nblk, nb = item % nblk, k0 = 64 * kb, n0 = 32 * nb;
#pragma unroll 8
    for (int i = 0; i < 32; ++i) { const int kk = 2 * i + (lane >> 5); scr[kk * 33 + (lane & 31)] = W[(size_t)(k0 + kk) * ldw + n0 + (lane & 31)]; }
    LDS_WAIT(); asm volatile("" ::: "memory");
#pragma unroll
    for (int j = 0; j < 2; ++j) { const int idx = lane + 64 * j, n = idx & 31, c = idx >> 5; const LAS float* s = scr + (16 * c) * 33 + n; float v[16];
#pragma unroll
        for (int i = 0; i < 16; ++i) v[i] = s[i * 33] * scale;
        v4u o; o.x = pk4_fp8(v[0], v[1], v[2], v[3]); o.y = pk4_fp8(v[4], v[5], v[6], v[7]); o.z = pk4_fp8(v[8], v[9], v[10], v[11]); o.w = pk4_fp8(v[12], v[13], v[14], v[15]);
        *(GAS v4u*)(WT + (size_t)map_row<MAP>(n0 + n) * K + k0 + 16 * c) = o; }
    LDS_WAIT(); asm volatile("" ::: "memory");
}
struct TrJob { const float* W; unsigned char* WT; int ldw, K, k0, n0, map, f8, row_off; float scale; };
__device__ __forceinline__ int map_row_rt(int map, int n) { return map == 0 ? n : (((n >> 7) << 8) + (map == 2 ? 128 : 0) + (n & 127)); }
__device__ __forceinline__ bool tr_get_job(Frame& F, int it, TrJob& j) {
    const float* const* in = F.in;
    constexpr int IU = 16 * 16, I1 = 16 * 48, I2 = 16 * 32, I3 = 16 * 88, I5 = 44 * 32, I6 = 16 * 36, I7 = 16 * 8, I9 = 4 * 8, IE1 = 16 * 112, IE2 = 56 * 32;
    constexpr int T0 = IU, T1 = T0 + I1, T2 = T1 + I2, T3 = T2 + I3, T4 = T3 + I3, T5 = T4 + I5, T6 = T5 + I6, T7 = T6 + I7, T8 = T7 + I2, T9 = T8 + I9, T10 = T9 + 8 * IE1, T11 = T10 + 8 * IE1, T12 = T11 + 8 * IE2;
    if (it >= T12) return false;
    int nblk, item, col0 = 0; j.map = 0; j.f8 = 0; j.row_off = 0; j.scale = 1.0f;
    if (it < T0)       { j.W = in[8];  j.ldw = 2048; j.K = 1024; nblk = 16; j.WT = F.ws + WS_WFT;   item = it; }
    else if (it < T1)  { j.W = in[8];  j.ldw = 2048; j.K = 1024; nblk = 48; j.WT = F.ws + WS_WQKVE; item = it - T0; col0 = 512; j.f8 = 1; j.scale = 32.0f; }
    else if (it < T2)  { j.W = in[12]; j.ldw = 1024; j.K = 1024; nblk = 32; j.WT = F.ws + WS_WOE;   item = it - T1; }
    else if (it < T3)  { j.W = in[13]; j.ldw = DFF;  j.K = 1024; nblk = 88; j.WT = F.ws + WS_W13E;  item = it - T2; j.map = 1; j.f8 = 1; j.scale = 32.0f; }
    else if (it < T4)  { j.W = in[14]; j.ldw = DFF;  j.K = 1024; nblk = 88; j.WT = F.ws + WS_W13E;  item = it - T3; j.map = 2; j.f8 = 1; j.scale = 32.0f; }
    else if (it < T5)  { j.W = in[15]; j.ldw = 1024; j.K = DFF;  nblk = 32; j.WT = F.ws + WS_W2E;   item = it - T4; }
    else if (it < T6)  { j.W = in[20]; j.ldw = 1408; j.K = 1024; nblk = 36; j.WT = F.ws + WS_WINO;  item = it - T5; j.f8 = 1; j.scale = 32.0f; }
    else if (it < T7)  { j.W = in[20]; j.ldw = 1408; j.K = 1024; nblk = 8;  j.WT = F.ws + WS_WINO;  item = it - T6; col0 = 1152; j.row_off = 1280; j.f8 = 1; j.scale = 32.0f; }
    else if (it < T8)  { j.W = in[33]; j.ldw = 1024; j.K = 1024; nblk = 32; j.WT = F.ws + WS_WOO;   item = it - T7; }
    else if (it < T9)  { j.W = in[31]; j.ldw = 256;  j.K = 256;  nblk = 8;  j.WT = F.ws + WS_GLUW;  item = it - T8; }
    else if (it < T10) { const int r = it - T9, e = r / IE1;  j.W = in[36] + (size_t)e * 1024 * DFE; j.ldw = DFE;  j.K = 1024; nblk = 112; j.WT = F.ws + WS_EW13 + (size_t)e * 7168 * 1024; item = r % IE1; j.map = 1; j.f8 = 1; j.scale = 32.0f; }
    else if (it < T11) { const int r = it - T10, e = r / IE1; j.W = in[37] + (size_t)e * 1024 * DFE; j.ldw = DFE;  j.K = 1024; nblk = 112; j.WT = F.ws + WS_EW13 + (size_t)e * 7168 * 1024; item = r % IE1; j.map = 2; j.f8 = 1; j.scale = 32.0f; }
    else               { const int r = it - T11, e = r / IE2; j.W = in[38] + (size_t)e * DFE * 1024; j.ldw = 1024; j.K = DFE;  nblk = 32;  j.WT = F.ws + WS_EW2 + (size_t)e * 1024 * DFE;   item = r % IE2; j.f8 = 1; j.scale = 64.0f; }
    j.k0 = 64 * (item / nblk); j.n0 = 32 * (item % nblk); j.W += col0;
    return true;
}
__device__ __forceinline__ void tr_load(const TrJob& j, int lane, f32x4 (&r)[8]) {
#pragma unroll
    for (int i = 0; i < 8; ++i) r[i] = *(const f32x4*)(j.W + (size_t)(j.k0 + 8 * i + (lane >> 3)) * j.ldw + j.n0 + (lane & 7) * 4);
}
__device__ __forceinline__ void tr_to_lds(LAS float* scr, int lane, const f32x4 (&r)[8]) {
#pragma unroll
    for (int i = 0; i < 8; ++i) { LAS float* d = scr + (8 * i + (lane >> 3)) * 33 + (lane & 7) * 4; d[0] = r[i].x; d[1] = r[i].y; d[2] = r[i].z; d[3] = r[i].w; }
}
__device__ __forceinline__ void tr_finish(const TrJob& j, LAS float* scr, int lane) {
    if (j.f8) {
#pragma unroll
        for (int q = 0; q < 2; ++q) { const int idx = lane + 64 * q, n = idx & 31, c = idx >> 5; const LAS float* s = scr + (16 * c) * 33 + n; float v[16];
#pragma unroll
            for (int i = 0; i < 16; ++i) v[i] = s[i * 33] * j.scale;
            v4u o; o.x = pk4_fp8(v[0], v[1], v[2], v[3]); o.y = pk4_fp8(v[4], v[5], v[6], v[7]); o.z = pk4_fp8(v[8], v[9], v[10], v[11]); o.w = pk4_fp8(v[12], v[13], v[14], v[15]);
            *(GAS v4u*)(j.WT + (size_t)(j.row_off + map_row_rt(j.map, j.n0 + n)) * j.K + j.k0 + 16 * c) = o; }
    } else { const int c = lane & 7;
#pragma unroll
        for (int q = 0; q < 4; ++q) { const int n = (lane >> 3) + 8 * q; const LAS float* s = scr + (8 * c) * 33 + n;
            v4u o; o.x = pk2(s[0 * 33], s[1 * 33]); o.y = pk2(s[2 * 33], s[3 * 33]); o.z = pk2(s[4 * 33], s[5 * 33]); o.w = pk2(s[6 * 33], s[7 * 33]);
            *(GAS v4u*)((bf16*)j.WT + (size_t)(j.row_off + map_row_rt(j.map, j.n0 + n)) * j.K + j.k0 + 8 * c) = o; }
    }
}
__device__ __forceinline__ void prologue_wave_items(Frame& F) {
    LAS float* scr = (LAS float*)(F.lds + RING_OFF + F.wave * 16384);
    const int gw = F.vcu * NWAVES + F.wave, NGW = F.G * NWAVES, lane = F.lane;
    { TrJob cur, nxt; f32x4 r[8]; int it = gw; bool have = tr_get_job(F, it, cur); if (have) tr_load(cur, lane, r);
      while (have) { tr_to_lds(scr, lane, r); it += NGW; const bool hn = tr_get_job(F, it, nxt); if (hn) tr_load(nxt, lane, r);
          LDS_WAIT(); asm volatile("" ::: "memory"); tr_finish(cur, scr, lane); LDS_WAIT(); asm volatile("" ::: "memory"); cur = nxt; have = hn; } }
    const int gt = gw * 64 + lane, NGT = NGW * 64;
    { v4u z = {0u, 0u, 0u, 0u}; v4u* p = (v4u*)(wsp<unsigned char>(F, WS_WINO) + (size_t)1152 * 1024); for (int i = gt; i < 128 * 1024 / 16; i += NGT) p[i] = z; }
    { bf16* T = wsp<bf16>(F, WS_D256L);
      for (int idx = gt; idx < 512 * 64; idx += NGT) { const int row = idx >> 6, col = (idx & 63) * 8, rip = row >> 8, k2 = row & 255, ri = col >> 8, n0 = col & 255; float v[8];
#pragma unroll
          for (int e = 0; e < 8; ++e) { const int j = (k2 * (n0 + e)) & 255; float s, c; sincospif((float)j * (1.0f / 128.0f), &s, &c); v[e] = (rip == ri ? c : (rip ? -s : s)) * (1.0f / 512.0f); }
          v4u o; o.x = pk2(v[0], v[1]); o.y = pk2(v[2], v[3]); o.z = pk2(v[4], v[5]); o.w = pk2(v[6], v[7]); *(v4u*)(T + (size_t)row * 512 + col) = o; } }
    { bf16* T = wsp<bf16>(F, WS_D256C);
      for (int idx = gt; idx < 512 * 32; idx += NGT) { const int row = idx >> 5, col = (idx & 31) * 8, rip = row >> 8, k = row & 255; float v[8];
#pragma unroll
          for (int e = 0; e < 8; ++e) { const int j = (k * (col + e)) & 255; float s, c; sincospif((float)j * (1.0f / 128.0f), &s, &c); v[e] = (rip ? -s : c) * 0.005524271728019903f; }
          v4u o; o.x = pk2(v[0], v[1]); o.y = pk2(v[2], v[3]); o.z = pk2(v[4], v[5]); o.w = pk2(v[6], v[7]); *(v4u*)(T + (size_t)row * 256 + col) = o; } }
    { bf16* T = wsp<bf16>(F, WS_FC);
      for (int idx = gt; idx < 256 * 64; idx += NGT) { const int row = idx >> 6, col = (idx & 63) * 8, gl = row >> 7, cp = row & 127, gl2 = col >> 8, ri = (col >> 7) & 1, c0 = col & 127; float v[8];
#pragma unroll
          for (int e = 0; e < 8; ++e) { const int j = (cp * (c0 + e)) & 127; float s, c; sincospif((float)j * (1.0f / 64.0f), &s, &c); v[e] = (gl == gl2) ? (ri ? s : c) : 0.f; }
          v4u o; o.x = pk2(v[0], v[1]); o.y = pk2(v[2], v[3]); o.z = pk2(v[4], v[5]); o.w = pk2(v[6], v[7]); *(v4u*)(T + (size_t)row * 512 + col) = o; } }
    { f32x2* T = wsp<f32x2>(F, WS_TWD);
      for (int idx = gt; idx < 5 * 256; idx += NGT) { const int k1 = idx >> 8, n2 = idx & 255; float s, c; sincospif((float)(k1 * n2) * (1.0f / 1024.0f), &s, &c); T[idx] = (f32x2){c, s}; } }
    { float* T = wsp<float>(F, WS_BTG); const float* rpb = F.in[11]; const float mfe = attn_mfix(F.in[9], F.in[10], F.in[11], 8 * 465, lane);
      if (gw == 0) { const float mfo_ = attn_mfix(F.in[21], F.in[22], nullptr, 0, lane); if (lane == 0) { ((float*)F.ctl)[CW_MFIX] = mfe; ((float*)F.ctl)[CW_MFIX + 1] = mfo_; } }
      for (int idx = gt; idx < 8 * 17 * 128 * 32; idx += NGT) { const int e4 = idx & 3, ls = (idx >> 2) & 127, j = (idx >> 9) & 7, kind = (idx >> 12) % 17, h = idx / (17 * 4096);
          const int e = 4 * j + e4, qc = (ls >> 6) * 32 + (ls & 31), hi_ = (ls >> 5) & 1, r = e & 15, kc = (r & 3) + 8 * (r >> 2) + 4 * hi_ + 32 * (e >> 4); int cs = qc - 8; cs = cs < 0 ? 0 : (cs > 48 ? 48 : cs);
          float v = -INFINITY; if (kind == 15) v = -mfe; else if (kind < 15 && kc >= cs && kc <= cs + 15) v = rpb[h * 465 + kind * 31 + (kc - qc + 15)] * LOG2E - mfe;
          T[idx] = v; } }
    { float* rc = wsp<float>(F, WS_ROPE); float* rs = rc + 2048 * 32;
      for (int idx = gt; idx < 2048 * 32; idx += NGT) { const int n = idx >> 5, i = idx & 31; const float pos = (float)((i < 16) ? (n >> 6) : (n & 63));
          const float fr = exp2f(-(float)(i & 15) * (13.287712379549449f / 16.0f)); float s, c; sincosf(pos * fr, &s, &c); rc[idx] = c; rs[idx] = s; } }
}
__device__ __forceinline__ void prologue_mod_item(Frame& F, int item) {
    const int layer = item / 96, cb = item % 96, w = F.wave, lane = F.lane; const int col = cb * 64 + lane;
    const float* mw = F.in[layer ? 16 : 4]; const float* mb = F.in[layer ? 17 : 5]; const float* cnd = F.in[1]; const float* cctx = F.in[3];
    LAS float* sl = (LAS float*)(F.lds + RING_OFF) + w * (64 * 36);
    float acc[33];
#pragma unroll
    for (int r = 0; r < 33; ++r) acc[r] = 0.f;
    for (int half = 0; half < 2; ++half) { const int kb = 128 * w + 64 * half;
#pragma unroll 3
        for (int r = 0; r < 33; ++r) { const float v = (r < 32) ? cnd[r * 1024 + kb + lane] : cctx[kb + lane]; sl[lane * 36 + r] = v / (1.0f + expf(-v)); }
        LDS_WAIT(); asm volatile("" ::: "memory");
#pragma unroll 1
        for (int kk0 = 0; kk0 < 64; kk0 += 16) { float wv16[16];
#pragma unroll
            for (int x = 0; x < 16; ++x) wv16[x] = mw[(size_t)(kb + kk0 + x) * 6144 + col];
#pragma unroll
            for (int x = 0; x < 16; ++x) { const int kk = kk0 + x; const float wv = wv16[x]; const LAS f32x4* sp = (const LAS f32x4*)(sl + kk * 36);
#pragma unroll
                for (int q = 0; q < 8; ++q) { const f32x4 s4 = sp[q]; acc[4 * q] += s4.x * wv; acc[4 * q + 1] += s4.y * wv; acc[4 * q + 2] += s4.z * wv; acc[4 * q + 3] += s4.w * wv; }
                acc[32] += sl[kk * 36 + 32] * wv; } }
        LDS_WAIT(); asm volatile("" ::: "memory"); }
    __syncthreads();
    LAS float* red = (LAS float*)(F.lds + RING_OFF);
#pragma unroll
    for (int r = 0; r < 33; ++r) red[(w * 33 + r) * 64 + lane] = acc[r];
    __syncthreads();
    float* MODp = wsp<float>(F, WS_MOD);
    for (int o = F.tid; o < 33 * 64; o += 512) { const int r = o >> 6, l = o & 63; float s = 0.f;
#pragma unroll
        for (int ww = 0; ww < 8; ++ww) s += red[(ww * 33 + r) * 64 + l];
        MODp[(size_t)(layer * 33 + r) * 6144 + cb * 64 + l] = s + mb[cb * 64 + l]; }
    __syncthreads();
}
__device__ __forceinline__ void prologue_s5_item(Frame& F, int g) {
    LAS f32x2* lbt = (LAS f32x2*)(F.lds + RING_OFF);
    LAS f32x2* bfc = lbt + 2 * 17 * 64;
    LAS f32x2* Bm = bfc + 128;
    LAS f32x2* Cm = Bm + 2048;
    LAS float* Kt = (LAS float*)(Cm + 2048);
    const int tid = F.tid; const float* const* in = F.in;
    if (tid < 128) { const int dir = tid >> 6, p = tid & 63, gi = (dir * 16 + g) * 64 + p; const float are = in[23][gi], aim = in[24][gi], stp = expf(in[25][dir * 16 + g]);
        for (int t = 0; t <= 16; ++t) { const float mag = expf((float)t * stp * are); float s, c; sincosf((float)t * stp * aim, &s, &c); lbt[(dir * 17 + t) * 64 + p] = (f32x2){mag * c, mag * s}; }
        const f32x2 l1 = lbt[(dir * 17 + 1) * 64 + p]; const float x = l1.x - 1.0f, y = l1.y, den = 1.0f / (are * are + aim * aim);
        bfc[dir * 64 + p] = (f32x2){(x * are + y * aim) * den, (y * are - x * aim) * den};
        wsp<f32x2>(F, WS_L16)[(g * 2 + dir) * 64 + p] = lbt[(dir * 17 + 16) * 64 + p]; }
    __syncthreads();
    for (int i = tid; i < 2048; i += 512) { const int dir = i >> 10, p = (i >> 4) & 63, n = i & 15; const size_t gi = ((size_t)(dir * 16 + g) * 64 + p) * 16 + n;
        const float br = in[26][gi], bi = in[27][gi]; const f32x2 f = bfc[dir * 64 + p]; Bm[i] = (f32x2){f.x * br - f.y * bi, f.x * bi + f.y * br}; }
    for (int i = tid; i < 2048; i += 512) { const int dir = i >> 10, m = (i >> 6) & 15, p = i & 63; const size_t gi = ((size_t)(dir * 16 + g) * 16 + m) * 64 + p; Cm[i] = (f32x2){in[28][gi], in[29][gi]}; }
    __syncthreads();
    for (int i = tid; i < 8192; i += 512) { const int dir = i >> 12, t = (i >> 8) & 15, m = (i >> 4) & 15, n = i & 15; float s = 0.f;
        for (int p = 0; p < 64; ++p) { const f32x2 c = Cm[(dir * 16 + m) * 64 + p], l = lbt[(dir * 17 + t) * 64 + p], b = Bm[(dir * 64 + p) * 16 + n];
            const float wr_ = c.x * l.x - c.y * l.y, wi_ = c.x * l.y + c.y * l.x; s += wr_ * b.x - wi_ * b.y; }
        Kt[i] = s; }
    __syncthreads();
    bf16* PST = wsp<bf16>(F, WS_PST) + (size_t)g * 65536; bf16* MQT = wsp<bf16>(F, WS_MQT) + (size_t)g * 131072;
    for (int ch = tid; ch < 8192; ch += 512) { const int q = ch >> 5, kk0 = (ch & 31) * 8, dir = q >> 7, ri = (q >> 6) & 1, p = q & 63, j = kk0 >> 4, n0 = kk0 & 15; const int e = dir ? j : 15 - j;
        const f32x2 l = lbt[(dir * 17 + e) * 64 + p]; float v[8];
#pragma unroll
        for (int x = 0; x < 8; ++x) { const f32x2 b = Bm[(dir * 64 + p) * 16 + n0 + x]; v[x] = ri ? (l.x * b.y + l.y * b.x) : (l.x * b.x - l.y * b.y); }
        v4u o; o.x = pk2(v[0], v[1]); o.y = pk2(v[2], v[3]); o.z = pk2(v[4], v[5]); o.w = pk2(v[6], v[7]); *(v4u*)(PST + (size_t)q * 256 + kk0) = o; }
    for (int ch = tid; ch < 16384; ch += 512) { const int row = ch >> 6, c0 = (ch & 63) * 8, i = row >> 4, m = row & 15; float v[8];
        if (c0 < 256) { const int j = c0 >> 4, n0 = c0 & 15;
#pragma unroll
            for (int x = 0; x < 8; ++x) { float s = 0.f; if (j <= i) s += Kt[((0 * 16 + (i - j)) * 16 + m) * 16 + n0 + x]; if (j >= i) s += Kt[((1 * 16 + (j - i)) * 16 + m) * 16 + n0 + x]; v[x] = s; } }
        else { const int cc = c0 - 256, dir = cc >> 7, ri = (cc >> 6) & 1, p0 = cc & 63; const int e = dir ? 16 - i : i + 1;
#pragma unroll
            for (int x = 0; x < 8; ++x) { const f32x2 c = Cm[(dir * 16 + m) * 64 + p0 + x], l = lbt[(dir * 17 + e) * 64 + p0 + x]; v[x] = ri ? -(c.x * l.y + c.y * l.x) : (c.x * l.x - c.y * l.y); } }
        v4u o; o.x = pk2(v[0], v[1]); o.y = pk2(v[2], v[3]); o.z = pk2(v[4], v[5]); o.w = pk2(v[6], v[7]); *(v4u*)(MQT + (size_t)row * 512 + c0) = o; }
    __syncthreads();
}

__device__ __forceinline__ void norm_row(const float* xrow, const float* gain, const float* shift, const float* scale, int lane, f32x4 (&h)[4]) {
    const f32x4* xr = (const f32x4*)xrow + lane; float ss = 0.f;
#pragma unroll
    for (int j = 0; j < 4; ++j) { h[j] = xr[64 * j]; ss += (h[j].x * h[j].x + h[j].y * h[j].y) + (h[j].z * h[j].z + h[j].w * h[j].w); }
    const float rstd = 1.0f / sqrtf(wave_sum(ss) * (1.0f / 1024.0f) + EPSN);
#pragma unroll
    for (int j = 0; j < 4; ++j) { const f32x4 g = ((const f32x4*)gain)[lane + 64 * j], sh = ((const f32x4*)shift)[lane + 64 * j], sc = ((const f32x4*)scale)[lane + 64 * j];
        h[j] = (h[j] * rstd * g) * (sc + 1.0f) + sh; }
}
__device__ __forceinline__ void store_row_bf16(bf16* orow, int lane, const f32x4 (&h)[4]) {
    unsigned long long* o8 = (unsigned long long*)orow + lane;
#pragma unroll
    for (int j = 0; j < 4; ++j) o8[64 * j] = (unsigned long long)pk2(h[j].x, h[j].y) | ((unsigned long long)pk2(h[j].z, h[j].w) << 32);
}
template <int F8OUT = 0, bool XB16 = false> __device__ __forceinline__ void norm_phase(Frame& F, const void* xl, const void* xc, const float* gain, int layer, int chunk0) {
    const int gw = F.vcu * NWAVES + F.wave, NGW = F.G * NWAVES, lane = F.lane; bf16* HN = wsp<bf16>(F, WS_HN);
    constexpr int NR = 4;
    for (int m0 = gw * NR; m0 < M; m0 += NGW * NR) { const int b = m0 / TPB, t = m0 % TPB;
        const int bi = (t < CTXL) ? 32 : b; f32x4 h[NR][4]; float ss[NR];
        if (XB16) { const bf16* xrow = (t < CTXL) ? (const bf16*)xc + (size_t)(b * CTXL + t) * D : (const bf16*)xl + (size_t)(b * SEQ + t - CTXL) * D;
#pragma unroll
            for (int r = 0; r < NR; ++r) { const v2u* xr = (const v2u*)(xrow + (size_t)r * D) + lane;
#pragma unroll
                for (int j = 0; j < 4; ++j) h[r][j] = bf4_to_f32(xr[64 * j]); } }
        else { const float* xrow = (t < CTXL) ? (const float*)xc + (size_t)(b * CTXL + t) * D : (const float*)xl + (size_t)(b * SEQ + t - CTXL) * D;
#pragma unroll
            for (int r = 0; r < NR; ++r) { const f32x4* xr = (const f32x4*)(xrow + (size_t)r * D) + lane;
#pragma unroll
                for (int j = 0; j < 4; ++j) h[r][j] = xr[64 * j]; } }
        const float* shift = modp(F, layer, bi, chunk0); const float* scale = modp(F, layer, bi, chunk0 + 1);
        f32x4 g4[4], sh4[4], sc4[4];
#pragma unroll
        for (int j = 0; j < 4; ++j) { g4[j] = ((const f32x4*)gain)[lane + 64 * j]; sh4[j] = ((const f32x4*)shift)[lane + 64 * j]; sc4[j] = ((const f32x4*)scale)[lane + 64 * j]; g4[j] = g4[j] * (sc4[j] + 1.0f); }
#pragma unroll
        for (int r = 0; r < NR; ++r) { float s = 0.f;
#pragma unroll
            for (int j = 0; j < 4; ++j) s += (h[r][j].x * h[r][j].x + h[r][j].y * h[r][j].y) + (h[r][j].z * h[r][j].z + h[r][j].w * h[r][j].w);
            ss[r] = s; }
#pragma unroll
        for (int o = 1; o < 64; o <<= 1) {
#pragma unroll
            for (int r = 0; r < NR; ++r) ss[r] += __shfl_xor(ss[r], o); }
#pragma unroll
        for (int r = 0; r < NR; ++r) { const float rstd = 1.0f / sqrtf(ss[r] * (1.0f / 1024.0f) + EPSN);
#pragma unroll
            for (int j = 0; j < 4; ++j) h[r][j] = (h[r][j] * rstd) * g4[j] + sh4[j];
            if (F8OUT) { unsigned* H8 = (F8OUT == 2) ? wsp<unsigned>(F, WS_TT) : (unsigned*)HN;
#pragma unroll
                for (int j = 0; j < 4; ++j) H8[(size_t)(m0 + r) * 256 + lane + 64 * j] = pk4_fp8(h[r][j].x, h[r][j].y, h[r][j].z, h[r][j].w); }
            if (F8OUT != 1) store_row_bf16(HN + (size_t)(m0 + r) * D, lane, h[r]); } }
}
template <bool ODD> __device__ __forceinline__ void qkprep_phase(Frame& F) {
    const int gw = F.vcu * NWAVES + F.wave, NGW = F.G * NWAVES, lane = F.lane;
    bf16* H1 = wsp<bf16>(F, WS_H1); const int P = ODD ? H1O_P : H1E_P;
    const float* qg = F.in[ODD ? 21 : 9]; const float* kg = F.in[ODD ? 22 : 10];
    const float* rc = wsp<const float>(F, WS_ROPE); const float* rs = rc + 2048 * 32;
    const int d0 = (lane & 7) * 8;
    float gq[8], gk[8];
#pragma unroll
    for (int e = 0; e < 8; ++e) { gq[e] = qg[d0 + e] * C2; gk[e] = kg[d0 + e]; }
    for (int m0 = gw * 4; m0 < M; m0 += NGW * 4) { v4u wv[4][2];
#pragma unroll
      for (int r = 0; r < 4; ++r)
#pragma unroll
        for (int ch = 0; ch < 2; ++ch) { const int col = ch * 512 + lane * 8; if (!ODD || col < 960) wv[r][ch] = *(const v4u*)(H1 + (size_t)(m0 + r) * P + col); }
#pragma unroll
      for (int r = 0; r < 4; ++r) { const int m = m0 + r; const int t = m % TPB; bf16* row = H1 + (size_t)m * P;
#pragma unroll
        for (int ch = 0; ch < 2; ++ch) { const int col = ch * 512 + lane * 8;
            const bool isq = ODD ? (col < 768) : (ch == 0); const bool act = ODD ? (col < 960) : true;
            if (act) { const v4u w = wv[r][ch]; float v[8];
                v[0] = bflo(w.x); v[1] = bfhi(w.x); v[2] = bflo(w.y); v[3] = bfhi(w.y); v[4] = bflo(w.z); v[5] = bfhi(w.z); v[6] = bflo(w.w); v[7] = bfhi(w.w);
                float ss = 0.f;
#pragma unroll
                for (int e = 0; e < 8; ++e) ss += v[e] * v[e];
                ss += __shfl_xor(ss, 1); ss += __shfl_xor(ss, 2); ss += __shfl_xor(ss, 4);
                const float rstd = 1.0f / sqrtf(ss * (1.0f / 64.0f) + EPSN);
#pragma unroll
                for (int e = 0; e < 8; ++e) v[e] = v[e] * rstd * (isq ? gq[e] : gk[e]);
                if (ODD && t >= CTXL) { const int n = t - CTXL; const f32x4 c4 = *(const f32x4*)(rc + n * 32 + (lane & 7) * 4), s4 = *(const f32x4*)(rs + n * 32 + (lane & 7) * 4);
#pragma unroll
                    for (int pr = 0; pr < 4; ++pr) { const float x1 = v[2 * pr], x2 = v[2 * pr + 1]; v[2 * pr] = x1 * c4[pr] - x2 * s4[pr]; v[2 * pr + 1] = x1 * s4[pr] + x2 * c4[pr]; } }
                v4u o; o.x = pk2(v[0], v[1]); o.y = pk2(v[2], v[3]); o.z = pk2(v[4], v[5]); o.w = pk2(v[6], v[7]); *(v4u*)(row + col) = o; } } } }
}
__device__ __forceinline__ void dft8_phase(Frame& F) {
    const bf16* UTL = wsp<const bf16>(F, WS_UTL); bf16* TT = wsp<bf16>(F, WS_TT); const f32x2* TWD = wsp<const f32x2>(F, WS_TWD);
    const int gt = (F.vcu * NWAVES + F.wave) * 64 + F.lane, NGT = F.G * NWAVES * 64; const float r = 0.70710678118654752f;
    for (int idx = gt; idx < NB * 512 * 32; idx += NGT) { const int n20 = (idx & 31) * 8, bc = idx >> 5;
        const bf16* src_ = UTL + (size_t)bc * 2048 + n20; v4u in[8];
#pragma unroll
        for (int n1 = 0; n1 < 8; ++n1) in[n1] = *(const v4u*)(src_ + 256 * n1);
        float ore[5][8], oim[5][8];
#pragma unroll
        for (int e = 0; e < 8; ++e) { float a[8];
#pragma unroll
            for (int n1 = 0; n1 < 8; ++n1) { const unsigned w = (e >> 1) == 0 ? in[n1].x : ((e >> 1) == 1 ? in[n1].y : ((e >> 1) == 2 ? in[n1].z : in[n1].w)); a[n1] = (e & 1) ? bfhi(w) : bflo(w); }
            const float d0 = a[0] - a[4], d1 = a[1] - a[5], d2 = a[2] - a[6], d3 = a[3] - a[7], s0 = a[0] + a[4], s1 = a[1] + a[5], s2 = a[2] + a[6], s3 = a[3] + a[7];
            float tre[5], tim[5];
            tre[0] = (s0 + s2) + (s1 + s3); tim[0] = 0.f;
            tre[4] = (s0 + s2) - (s1 + s3); tim[4] = 0.f;
            tre[1] = d0 + r * (d1 - d3); tim[1] = -d2 - r * (d1 + d3);
            tre[2] = s0 - s2; tim[2] = s3 - s1;
            tre[3] = d0 - r * (d1 - d3); tim[3] = d2 - r * (d1 + d3);
            ore[0][e] = tre[0]; oim[0][e] = 0.f;
#pragma unroll
            for (int k1 = 1; k1 < 5; ++k1) { const f32x2 cs = TWD[k1 * 256 + n20 + e]; ore[k1][e] = tre[k1] * cs.x + tim[k1] * cs.y; oim[k1][e] = tim[k1] * cs.x - tre[k1] * cs.y; } }
        const int b = bc >> 9, c = bc & 511;
#pragma unroll
        for (int k1 = 0; k1 < 5; ++k1) { bf16* dst = TT + ((size_t)(b * 5 + k1) * 512 + c) * 512 + n20;
            v4u o; o.x = pk2(ore[k1][0], ore[k1][1]); o.y = pk2(ore[k1][2], ore[k1][3]); o.z = pk2(ore[k1][4], ore[k1][5]); o.w = pk2(ore[k1][6], ore[k1][7]); *(v4u*)dst = o;
            o.x = pk2(oim[k1][0], oim[k1][1]); o.y = pk2(oim[k1][2], oim[k1][3]); o.z = pk2(oim[k1][4], oim[k1][5]); o.w = pk2(oim[k1][6], oim[k1][7]); *(v4u*)(dst + 256) = o; } }
}
__device__ __forceinline__ void s5_scan_phase(Frame& F) {
    const int v0 = (F.G >= 256) ? F.vcu - (F.G - 128) : F.vcu; if (v0 < 0) return;
    const int id = v0 * 512 + F.tid; if (id >= 65536) return;
    const int p = id & 63, dir = (id >> 6) & 1, b = (id >> 7) & 31, g = id >> 12;
    const f32x2 l16 = wsp<const f32x2>(F, WS_L16)[(g * 2 + dir) * 64 + p];
    const unsigned short* S = wsp<const unsigned short>(F, WS_S) + ((size_t)g * 4608 + b * 144) * 256 + dir * 128 + p;
    bf16* X = wsp<bf16>(F, WS_AB) + ((size_t)g * 4608 + b * 144) * 512 + 256 + dir * 128 + p;
    float xr = 0.f, xi = 0.f;
    for (int k0 = 0; k0 < 144; k0 += 8) {
        float sr[8], si[8];
#pragma unroll
        for (int q = 0; q < 8; ++q) { const int k = k0 + q; const int c = (dir == 0) ? k : ((k < 16) ? 15 - k : 159 - k); sr[q] = __uint_as_float((unsigned)S[(size_t)c * 256] << 16); si[q] = __uint_as_float((unsigned)S[(size_t)c * 256 + 64] << 16); }
#pragma unroll
        for (int q = 0; q < 8; ++q) { const int k = k0 + q; const int c = (dir == 0) ? k : ((k < 16) ? 15 - k : 159 - k);
            X[(size_t)c * 512] = (bf16)f2bf(xr); X[(size_t)c * 512 + 64] = (bf16)f2bf(xi);
            const float nr = l16.x * xr - l16.y * xi + sr[q], ni = l16.x * xi + l16.y * xr + si[q]; xr = nr; xi = ni; } }
}
__device__ __forceinline__ void router_phase(Frame& F) {
    LAS int* lcnt = (LAS int*)(F.lds + RING_OFF);
    LAS int* lbase = lcnt + 16;
    LAS int* lte = lcnt + 32; LAS int* ltr = lte + 512; LAS float* ltw = (LAS float*)(ltr + 512);
    const int tid = F.tid, lane = F.lane, w = F.wave;
    int* stok = wsp<int>(F, WS_STOK);
    for (int i = F.vcu * 512 + tid; i < MAXSLOT; i += F.G * 512) stok[i] = -1;
    const float* rw = F.in[34]; const float* rb = F.in[35]; const float* gain = F.in[19];
    int* TKE = wsp<int>(F, WS_TKE); int* TKR = wsp<int>(F, WS_TKR); float* TKW = wsp<float>(F, WS_TKW); unsigned* HN8 = wsp<unsigned>(F, WS_HN);
    LAS f32x4* rwL = (LAS f32x4*)(F.lds + RING_OFF + 8192);
    for (int i = tid; i < 32 * 64; i += 512) { const int l = i & 63, kh = i >> 6, k = kh >> 1, half = kh & 1, jj = k >> 2, x = k & 3; rwL[i] = ((const f32x4*)(rw + (size_t)(4 * l + 256 * jj + x) * 8))[half]; }
    LDS_WAIT(); __syncthreads();
#define RWV(k, half) rwL[((k) * 2 + (half)) * 64 + lane]
    float rbv[8];
#pragma unroll
    for (int e = 0; e < 8; ++e) rbv[e] = rb[e];
    const bool b5 = (lane & 32) != 0, b4 = (lane & 16) != 0, b3 = (lane & 8) != 0;
#define DOT8_REDUCE(v, out) do { float w_[4], u_[2]; \
        _Pragma("unroll") for (int i_ = 0; i_ < 4; ++i_) { const float snd = b5 ? v[i_] : v[4 + i_]; const float rcv = __shfl_xor(snd, 32); w_[i_] = (b5 ? v[4 + i_] : v[i_]) + rcv; } \
        _Pragma("unroll") for (int i_ = 0; i_ < 2; ++i_) { const float snd = b4 ? w_[i_] : w_[2 + i_]; const float rcv = __shfl_xor(snd, 16); u_[i_] = (b4 ? w_[2 + i_] : w_[i_]) + rcv; } \
        { const float snd = b3 ? u_[0] : u_[1]; const float rcv = __shfl_xor(snd, 8); out = (b3 ? u_[1] : u_[0]) + rcv; } \
        out += __shfl_xor(out, 4); out += __shfl_xor(out, 2); out += __shfl_xor(out, 1); } while (0)
    for (int blk = F.vcu; blk < MLAT / 256; blk += F.G) {
        if (tid < 16) lcnt[tid] = 0;
        __syncthreads();
        const int b = (blk * 256) >> 11;
        f32x4 g4[4], sh4[4];
#pragma unroll
        for (int jj = 0; jj < 4; ++jj) { g4[jj] = ((const f32x4*)gain)[lane + 64 * jj] * (((const f32x4*)modp(F, 1, b, 4))[lane + 64 * jj] + 1.0f); sh4[jj] = ((const f32x4*)modp(F, 1, b, 3))[lane + 64 * jj]; }
        float c0[8];
        { float pv[8];
#pragma unroll
          for (int e = 0; e < 8; ++e) pv[e] = 0.f;
#pragma unroll
          for (int jj = 0; jj < 4; ++jj)
#pragma unroll
              for (int x = 0; x < 4; ++x) { const float hv = sh4[jj][x]; const f32x4 w0 = RWV(jj * 4 + x, 0), w1 = RWV(jj * 4 + x, 1);
                  pv[0] += hv * w0.x; pv[1] += hv * w0.y; pv[2] += hv * w0.z; pv[3] += hv * w0.w; pv[4] += hv * w1.x; pv[5] += hv * w1.y; pv[6] += hv * w1.z; pv[7] += hv * w1.w; }
          float t; DOT8_REDUCE(pv, t);
#pragma unroll
          for (int e = 0; e < 8; ++e) c0[e] = __shfl(t, 8 * e) + rbv[e]; }
        const int tok0 = blk * 256 + w * 32;
        f32x4 xn[4];
#pragma unroll
        for (int jj = 0; jj < 4; ++jj) xn[jj] = bf4_to_f32(((const v2u*)(F.XL + (size_t)tok0 * D))[lane + 64 * jj]);
        for (int j = 0; j < 32; ++j) { const int tok = tok0 + j; f32x4 y[4];
#pragma unroll
            for (int jj = 0; jj < 4; ++jj) y[jj] = xn[jj];
            if (j < 31) {
#pragma unroll
                for (int jj = 0; jj < 4; ++jj) xn[jj] = bf4_to_f32(((const v2u*)(F.XL + (size_t)(tok + 1) * D))[lane + 64 * jj]); }
            float ss = 0.f, pv[8];
#pragma unroll
            for (int e = 0; e < 8; ++e) pv[e] = 0.f;
#pragma unroll
            for (int jj = 0; jj < 4; ++jj) { ss += (y[jj].x * y[jj].x + y[jj].y * y[jj].y) + (y[jj].z * y[jj].z + y[jj].w * y[jj].w); y[jj] = y[jj] * g4[jj];
#pragma unroll
                for (int x = 0; x < 4; ++x) { const float hv = y[jj][x]; const f32x4 w0 = RWV(jj * 4 + x, 0), w1 = RWV(jj * 4 + x, 1);
                    pv[0] += hv * w0.x; pv[1] += hv * w0.y; pv[2] += hv * w0.z; pv[3] += hv * w0.w; pv[4] += hv * w1.x; pv[5] += hv * w1.y; pv[6] += hv * w1.z; pv[7] += hv * w1.w; } }
            float t; DOT8_REDUCE(pv, t);
            const float rstd = 1.0f / sqrtf(wave_sum(ss) * (1.0f / 1024.0f) + EPSN);
            float lg[8];
#pragma unroll
            for (int e = 0; e < 8; ++e) lg[e] = __shfl(t, 8 * e) * rstd + c0[e];
#pragma unroll
            for (int jj = 0; jj < 4; ++jj) { const f32x4 h = y[jj] * rstd + sh4[jj]; HN8[(size_t)tok * 256 + lane + 64 * jj] = pk4_fp8(h.x, h.y, h.z, h.w); }
            int e1 = 0; float v1 = lg[0];
#pragma unroll
            for (int e = 1; e < 8; ++e) if (lg[e] > v1) { v1 = lg[e]; e1 = e; }
            int e2 = -1; float v2 = -INFINITY;
#pragma unroll
            for (int e = 0; e < 8; ++e) if (e != e1 && lg[e] > v2) { v2 = lg[e]; e2 = e; }
            const float w2 = 1.0f / (1.0f + expf(v1 - v2)), w1 = 1.0f - w2;
            if (lane == 0) { const int r1 = __hip_atomic_fetch_add(lcnt + e1, 1, __ATOMIC_RELAXED, __HIP_MEMORY_SCOPE_WORKGROUP), r2 = __hip_atomic_fetch_add(lcnt + 8 + e2, 1, __ATOMIC_RELAXED, __HIP_MEMORY_SCOPE_WORKGROUP);
                const int lt = w * 32 + j; lte[lt * 2] = e1; lte[lt * 2 + 1] = e2; ltr[lt * 2] = r1; ltr[lt * 2 + 1] = r2; ltw[lt * 2] = w1; ltw[lt * 2 + 1] = w2; } }
        LDS_WAIT(); __syncthreads();
        if (tid < 16) lbase[tid] = (int)__hip_atomic_fetch_add(F.ctl + CW_MOE + 64 * tid, (unsigned)lcnt[tid], RLX_AGENT);
        __syncthreads();
        if (tid < 256) { const int tok = blk * 256 + tid; const int e1 = lte[tid * 2], e2 = lte[tid * 2 + 1];
            TKE[tok * 2] = e1; TKE[tok * 2 + 1] = e2; TKR[tok * 2] = ltr[tid * 2] + lbase[e1]; TKR[tok * 2 + 1] = ltr[tid * 2 + 1] + lbase[8 + e2]; TKW[tok * 2] = ltw[tid * 2]; TKW[tok * 2 + 1] = ltw[tid * 2 + 1]; }
        __syncthreads();
    }
#undef DOT8_REDUCE
#undef RWV
}
__device__ __forceinline__ int moe_layout(Frame& F, int (&ps)[17]) {
    int acc = 0;
#pragma unroll
    for (int j = 0; j < 16; ++j) { ps[j] = acc; const int c = (int)__builtin_amdgcn_readfirstlane(__hip_atomic_load(F.ctl + CW_MOE + 64 * j, RLX_AGENT)); acc += (c + 255) >> 8; }
    ps[16] = acc; return acc;
}
__device__ __forceinline__ void gather_phase(Frame& F) {
    int ps[17]; moe_layout(F, ps);
    if (blockIdx.x == 0) { const int tid = F.tid;
        for (int pnl = tid; pnl < ps[16]; pnl += 512) { int e = 0;
#pragma unroll
            for (int j = 1; j < 16; ++j) if (pnl >= ps[j]) e = j;
            __hip_atomic_store(F.ctl + CW_PEXP + pnl, (unsigned)(e & 7), RLX_AGENT); }
        if (tid == 0) { __hip_atomic_store(F.ctl + CW_CHUNK, (unsigned)ps[8], RLX_AGENT); __hip_atomic_store(F.ctl + CW_CHUNK + 1, (unsigned)ps[16], RLX_AGENT); } }
    const int gw = F.vcu * NWAVES + F.wave, NGW = F.G * NWAVES, lane = F.lane;
    const int* TKE = wsp<const int>(F, WS_TKE); const int* TKR = wsp<const int>(F, WS_TKR); const float* TKW = wsp<const float>(F, WS_TKW);
    int* stok = wsp<int>(F, WS_STOK); float* sw = wsp<float>(F, WS_SW); const v4u* HN8 = wsp<const v4u>(F, WS_HN); unsigned char* HNG = wsp<unsigned char>(F, WS_HNG);
    for (int tok0 = gw * 8; tok0 < MLAT; tok0 += NGW * 8) { v4u a0[8]; int ee[8][2], rr[8][2];
#pragma unroll
        for (int r = 0; r < 8; ++r) { const int tok = tok0 + r; a0[r] = HN8[(size_t)tok * 64 + lane];
            ee[r][0] = TKE[tok * 2]; ee[r][1] = TKE[tok * 2 + 1]; rr[r][0] = TKR[tok * 2]; rr[r][1] = TKR[tok * 2 + 1]; }
#pragma unroll
        for (int r = 0; r < 8; ++r) { const int tok = tok0 + r;
#pragma unroll
            for (int h = 0; h < 2; ++h) { int base = 0;
#pragma unroll
                for (int j = 0; j < 16; ++j) if (j == h * 8 + ee[r][h]) base = ps[j];
                const int slot = base * 256 + rr[r][h];
                *((v4u*)(HNG + (size_t)slot * D) + lane) = a0[r];
                if (lane == 0) { stok[slot] = tok; sw[slot] = TKW[tok * 2 + h]; } } } }
}

struct Args { const float* in[39]; float* out; unsigned char* ws; int ph_lo, ph_hi, li, pad; };
__global__ void __launch_bounds__(NWAVES * 64, 2) mk_fwd(Args args) {
    extern __shared__ __attribute__((aligned(16))) unsigned char lds[];
    Frame F;
    F.lds = (LAS unsigned char*)lds;
    F.MISC = (volatile LAS unsigned*)(F.lds + MISC_OFF);
    F.tid = threadIdx.x; F.lane = F.tid & 63; F.wave = __builtin_amdgcn_readfirstlane(F.tid >> 6);
    F.G = gridDim.x; { const int bx = blockIdx.x; F.vcu = (F.G % 8 == 0) ? (bx % 8) * (F.G / 8) + bx / 8 : bx; }
    F.in = args.in; F.ws = args.ws; F.ctl = (unsigned*)(args.ws + WS_CTL);
    F.XL = (bf16*)((char*)args.out + (size_t)128 * MiB); F.OUT = args.out; F.X3P = (bf16*)(args.ws + WS_HN); F.XC = (bf16*)(args.ws + WS_XC);
    for (int u = F.tid; u < (LDS_BYTES - LDSCTL_OFF) / 4; u += NWAVES * 64) ((LAS unsigned*)(F.lds + LDSCTL_OFF))[u] = 0u;
    __syncthreads();
    XcdBarrier bar; bar.bar = F.ctl + CW_BAR + (MK_PER_PHASE ? 0 : args.li) * XCD_BAR_WORDS; bar.x = 0; bar.st = nullptr;
    if (!MK_PER_PHASE) bar = xcd_barrier_post(F.ctl + CW_BAR + args.li * XCD_BAR_WORDS, F.MISC + 8);
#define GRID_BAR() do { if (MK_PER_PHASE) { if (F.tid == 0) __hip_atomic_store(F.ctl + CW_TMO, 0xBADBA0u, RLX_AGENT); } else { xcd_barrier(bar); } } while (0)
    const int lo = args.ph_lo, hi = args.ph_hi;
#ifndef PHMASK
#define PHMASK 0xFFFFFFFFu
#endif
#define IN(k) (((PHMASK >> (k)) & 1u) && lo <= (k) && (k) < hi)
#define FLAG_ARRIVE(j) do { asm volatile("s_waitcnt vmcnt(0)" ::: "memory"); __syncthreads(); if (F.tid == 0) { __builtin_amdgcn_fence(__ATOMIC_RELEASE, "agent"); asm volatile("s_waitcnt vmcnt(0)" ::: "memory"); (void)xb_add(F.ctl + CW_FLAG + 64 * (j), 1u); } } while (0)
#define FLAG_WAIT(j) do { if (F.tid == 0) { XB_SPIN(xb_ld(F.ctl + CW_FLAG + 64 * (j)) < (unsigned)F.G, bar.bar); __builtin_amdgcn_fence(__ATOMIC_ACQUIRE, "agent"); asm volatile("s_waitcnt vmcnt(0)" ::: "memory"); } __syncthreads(); } while (0)
#ifndef REPMASK
#define REPMASK 0u
#endif
#define REPS(k) for (int rep_ = 0; rep_ < (((REPMASK >> (k)) & 1u) ? 2 : 1); ++rep_)
#define SEAM(k) do { if (IN(k) && IN((k) + 1)) GRID_BAR(); } while (0)
    const int bx = (int)blockIdx.x;
    bf16* HN = wsp<bf16>(F, WS_HN); bf16* H1 = wsp<bf16>(F, WS_H1); bf16* OB = wsp<bf16>(F, WS_O); bf16* OBE = wsp<bf16>(F, WS_OE);
    const float* MOD0 = wsp<const float>(F, WS_MOD); const float* MOD1 = MOD0 + 33 * 6144;
    LAS unsigned char* ring = F.lds + RING_OFF;

    if (IN(0)) REPS(0) {
        for (int it = bx; it < 208; it += F.G) { if (it < 192) prologue_mod_item(F, it); else prologue_s5_item(F, it - 192); }
        prologue_wave_items(F);
        VM_WAIT(); __syncthreads();
    }
    SEAM(0);
    if (IN(1)) norm_phase<2>(F, F.in[0], F.in[2], F.in[6], 0, 0);
    SEAM(1);
    if (IN(2)) REPS(2) {
        { pg8::Gemm g{wsp<const bf16>(F, WS_WFT), HN, 1024, 1024, 1024}; pg8::Order S; S.init(2, NPAN, F.G, bx, pg8::OM_PLAIN, 2, (size_t)256 * 1024 * 2, (size_t)256 * 1024 * 2, 0, 0);
          EpiFourT E{wsp<bf16>(F, WS_UTL), wsp<bf16>(F, WS_UTC)}; pg8::gemm_phase<EpiFourT, pg8::Order, true>(ring, g, S, E); }
        { pg8::Gemm g{wsp<const bf16>(F, WS_TT), wsp<const bf16>(F, WS_WQKVE), 1024, 1024, 1024}; pg8::Order S; S.init(NPAN, 6, F.G, (bx + 192) % F.G, pg8::OM_PLAIN, NPAN, (size_t)256 * 1024, (size_t)256 * 1024, 0, 0);
          EpiQKV<false> E{H1, nullptr, F.in[9], F.in[10], nullptr, nullptr, (LAS float*)(F.lds + LDSCTL_OFF + 1024), 0.03125f, 0}; pg8::gemm_phase<EpiQKV<false>, pg8::Order, true, true>(ring, g, S, E); }
    }
    SEAM(2);
    if (IN(3)) { dft8_phase(F); }
    SEAM(3);
    if (IN(4)) REPS(4) {
        { pg8::Gemm g{wsp<const bf16>(F, WS_D256L), wsp<const bf16>(F, WS_TT), 512, 512, 512}; pg8::Order S; S.init(NB * 5 * 2, 2, F.G, bx, pg8::OM_ZB, 2, (size_t)256 * 512 * 2, (size_t)256 * 512 * 2, 0, (size_t)512 * 512 * 2);
          EpiVT E{wsp<bf16>(F, WS_VT), 1}; pg8::gemm_phase<EpiVT, pg8::Order, true>(ring, g, S, E); }
        { pg8::Gemm g{wsp<const bf16>(F, WS_D256C), wsp<const bf16>(F, WS_UTC), 256, 256, 256}; pg8::Order S; S.init(NB * 2, 2, F.G, (bx + 128) % F.G, pg8::OM_ZB, 2, (size_t)256 * 256 * 2, (size_t)256 * 256 * 2, 0, (size_t)512 * 256 * 2);
          EpiVT E{wsp<bf16>(F, WS_VT), 0}; pg8::gemm_phase<EpiVT, pg8::Order, true>(ring, g, S, E); }
        { const int b = F.vcu >> 3, h = F.vcu & 7; const float mfe = __int_as_float(__builtin_amdgcn_readfirstlane((int)__hip_atomic_load(F.ctl + CW_MFIX, RLX_AGENT)));
          if (F.vcu < 256) {
            const attn_body::bf16* base = (const attn_body::bf16*)H1 + (size_t)b * TPB * H1E_P;
            for (int qb = 0; qb < 8; ++qb) { attn_body::AttnJob J;
                J.Q = base + (size_t)(CTXL + 256 * qb) * H1E_P + h * 64; J.K = base + 512 + h * 64; J.V = base + 1024 + h * 64;
                J.O = (attn_body::bf16*)OBE + ((size_t)b * TPB + CTXL + 256 * qb) * 1024 + 512 + h * 64; J.qp = H1E_P; J.kvp = H1E_P; J.op = 1024;
                J.NT = (qb == 0 || qb == 7) ? 12 : 16; J.KR0 = (qb == 0) ? 0 : ((qb == 7) ? 24 : 4 * qb - 4); J.qb = qb; J.BT = wsp<const float>(F, WS_BTG) + (size_t)h * 17 * 4096; J.mfix = mfe;
                attn_body::attn_unit<1, 8>(J, (char*)lds + RING_OFF); }
            { attn_body::AttnJob J; J.Q = base + h * 64; J.K = base + 512 + h * 64; J.V = base + 1024 + h * 64; J.O = (attn_body::bf16*)OBE + ((size_t)b * TPB) * 1024 + 512 + h * 64;
              J.qp = H1E_P; J.kvp = H1E_P; J.op = 1024; J.NT = 4; J.KR0 = 0; J.qb = 0; J.BT = nullptr; J.mfix = mfe; attn_body::attn_unit<0, 8>(J, (char*)lds + RING_OFF); } } }
    }
    SEAM(4);
    if (IN(5)) { pg8::Gemm g{wsp<const bf16>(F, WS_VT), wsp<const bf16>(F, WS_FC), 1024, 512, 512}; pg8::Order S; S.init(2 * NPAN, 1, F.G, bx, pg8::OM_ZAB, NPAN, (size_t)256 * 1024 * 2, 0, (size_t)512 * 2, 0);
        EpiPlainBf16 E{OBE, 1024, 0, 0, 256}; pg8::gemm_phase<EpiPlainBf16, pg8::Order, true>(ring, g, S, E); }
    SEAM(5);
    if (IN(6)) REPS(6) { pg8::Gemm g{OBE, wsp<const bf16>(F, WS_WOE), 1024, 1024, 1024}; pg8::Order S; S.init(NPAN, 4, F.G, bx, pg8::OM_PLAIN, NPAN, (size_t)256 * 1024 * 2, (size_t)256 * 1024 * 2, 0, 0);
        EpiResid<true> E{F.in[0], F.in[2], F.XL, F.XC, MOD0, 2}; pg8::gemm_phase<EpiResid<true>, pg8::Order, true>(ring, g, S, E); }
    SEAM(6);
    if (IN(7)) norm_phase<1, true>(F, F.XL, F.XC, F.in[7], 0, 3);
    SEAM(7);
    if (IN(8)) REPS(8) { pg8::Gemm g{HN, wsp<const bf16>(F, WS_W13E), 1024, 1024, 1024}; pg8::Order S; S.init(NPAN, 22, F.G, bx, pg8::OM_PLAIN, NPAN, (size_t)256 * 1024, (size_t)256 * 1024, 0, 0);
        EpiSwiglu<false> E{wsp<unsigned char>(F, WS_HMID), DFF, 0, 0.03125f, 0.03125f}; pg8::gemm_phase<EpiSwiglu<false>, pg8::Order, true, true>(ring, g, S, E); }
    SEAM(8);
    if (IN(9)) { pg8::Gemm g{wsp<const bf16>(F, WS_HMID), wsp<const bf16>(F, WS_W2E), DFF, DFF, DFF}; pg8::Order S; S.init(NPAN, 4, F.G, bx, pg8::OM_PLAIN, NPAN, (size_t)256 * DFF * 2, (size_t)256 * DFF * 2, 0, 0);
        EpiResid<false> E{F.XL, F.XC, F.XL, F.XC, MOD0, 5}; pg8::gemm_phase<EpiResid<false>, pg8::Order, true>(ring, g, S, E); }
    SEAM(9);
    if (IN(10)) norm_phase<1, true>(F, F.XL, F.XC, F.in[18], 1, 0);
    SEAM(10);
    if (IN(11)) {
        { pg8::Gemm g{HN, wsp<const bf16>(F, WS_WINO), 1024, 1024, 1024}; pg8::Order S; S.init(NPAN, 6, F.G, bx, pg8::OM_PLAIN, NPAN, (size_t)256 * 1024, (size_t)256 * 1024, 0, 0);
          EpiQKV<true> E{H1, wsp<bf16>(F, WS_AB), F.in[21], F.in[22], wsp<const float>(F, WS_ROPE), wsp<const float>(F, WS_ROPE) + 2048 * 32, (LAS float*)(F.lds + LDSCTL_OFF + 1024), 0.03125f, 0};
          pg8::gemm_phase<EpiQKV<true>, pg8::Order, true, true>(ring, g, S, E); }
    }
    SEAM(11);
    if (IN(12)) {
#define GQA_UNITS(i0, i1) for (int i = (i0); i < (i1) && i * F.G + F.vcu < NB * 12 * 8; ++i) { const int id = i * F.G + F.vcu, qb = id & 7, gq = (id >> 3) & 3, bh = id >> 5, b = bh / 3, hk = bh % 3, h = hk * 4 + gq; \
            const attn_body::bf16* base = (const attn_body::bf16*)H1 + (size_t)b * TPB * H1O_P; attn_body::AttnJob J; \
            J.Q = base + (size_t)(CTXL + 256 * qb) * H1O_P + h * 64; J.K = base + 768 + hk * 64; J.V = base + 960 + hk * 64; \
            J.O = (attn_body::bf16*)OB + ((size_t)b * TPB + CTXL + 256 * qb) * 1024 + h * 64; J.qp = H1O_P; J.kvp = H1O_P; J.op = 1024; J.NT = 36; J.KR0 = 0; J.qb = 0; J.BT = nullptr; J.mfix = mfo; \
            attn_body::attn_unit<0, 8>(J, (char*)lds + RING_OFF); }
        const int nq = (NB * 12 * 8 + F.G - 1) / F.G, q1 = nq / 3, q2 = (2 * nq) / 3; const float mfo = __int_as_float(__builtin_amdgcn_readfirstlane((int)__hip_atomic_load(F.ctl + CW_MFIX + 1, RLX_AGENT)));
        { pg8::Gemm g{wsp<const bf16>(F, WS_AB), wsp<const bf16>(F, WS_PST), 512, 256, 256}; pg8::Order S; S.init(16 * 18, 1, F.G, bx, pg8::OM_ZAB, 18, (size_t)256 * 512 * 2, (size_t)256 * 256 * 2, (size_t)4608 * 512 * 2, (size_t)256 * 256 * 2);
          EpiPlainBf16 E{wsp<bf16>(F, WS_S), 256, 4608, 0, 0}; pg8::gemm_phase<EpiPlainBf16, pg8::Order, true>(ring, g, S, E); }
        FLAG_ARRIVE(0);
        GQA_UNITS(0, q1)
        FLAG_WAIT(0);
        s5_scan_phase(F);
        FLAG_ARRIVE(1);
        GQA_UNITS(q1, q2)
        FLAG_WAIT(1);
        { pg8::Gemm g{wsp<const bf16>(F, WS_AB), wsp<const bf16>(F, WS_MQT), 512, 512, 512}; pg8::Order S; S.init(16 * 18, 1, F.G, (bx + 64) % F.G, pg8::OM_ZAB, 18, (size_t)256 * 512 * 2, (size_t)256 * 512 * 2, (size_t)4608 * 512 * 2, (size_t)256 * 512 * 2);
          EpiS5B E{wsp<const bf16>(F, WS_AB), F.in[30], wsp<bf16>(F, WS_Z)}; pg8::gemm_phase<EpiS5B, pg8::Order, true>(ring, g, S, E); }
        FLAG_ARRIVE(2);
        GQA_UNITS(q2, nq)
        FLAG_WAIT(2);
        { pg8::Gemm g{wsp<const bf16>(F, WS_Z), wsp<const bf16>(F, WS_GLUW), 256, 256, 256}; pg8::Order S; S.init(256, 1, F.G, bx, pg8::OM_LAT, 256, (size_t)256 * 256 * 2, (size_t)256 * 256 * 2, 0, 0);
          EpiGLU E{wsp<const bf16>(F, WS_Z), F.in[32], OB}; pg8::gemm_phase<EpiGLU, pg8::Order, true>(ring, g, S, E); }
#undef GQA_UNITS
    }
    if (IN(12) && IN(16)) GRID_BAR();

    if (IN(16)) { pg8::Gemm g{OB, wsp<const bf16>(F, WS_WOO), 1024, 1024, 1024}; pg8::Order S; S.init(256, 4, F.G, bx, pg8::OM_LAT, 256, (size_t)256 * 1024 * 2, (size_t)256 * 1024 * 2, 0, 0);
        EpiResid<false> E{F.XL, F.XC, F.XL, F.XC, MOD1, 2}; pg8::gemm_phase<EpiResid<false>, pg8::Order, true>(ring, g, S, E); }
    SEAM(16);
    if (IN(17)) { router_phase(F); }
    SEAM(17);
    if (IN(18)) REPS(18) { gather_phase(F); }
    SEAM(18);
    if (IN(19)) REPS(19) { const int ptot = (int)__builtin_amdgcn_readfirstlane(__hip_atomic_load(F.ctl + CW_CHUNK + 1, RLX_AGENT));
        pg8::Gemm g{wsp<const bf16>(F, WS_HNG), wsp<const bf16>(F, WS_EW13), 1024, 1024, 1024}; pg8::Order S; S.init(ptot, 28, F.G, bx, pg8::OM_MOE, ptot, (size_t)256 * 1024, (size_t)256 * 1024, 0, (size_t)7168 * 1024);
        S.pexp = F.ctl + CW_PEXP; S.pbase = 0; S.apan0 = 0;
        EpiSwiglu<true> E{wsp<unsigned char>(F, WS_HME), DFE, 0, 0.03125f, 0.25f}; pg8::gemm_phase<EpiSwiglu<true>, pg8::Order, true, true>(ring, g, S, E); }
    SEAM(19);
#define MOE_DOWN(half, ph) \
    if (IN(ph)) { const int p0 = (int)__builtin_amdgcn_readfirstlane(__hip_atomic_load(F.ctl + CW_CHUNK, RLX_AGENT)), pt = (int)__builtin_amdgcn_readfirstlane(__hip_atomic_load(F.ctl + CW_CHUNK + 1, RLX_AGENT)); \
        const int cbase = (half) ? p0 : 0, cnp = (half) ? pt - p0 : p0; \
        pg8::Gemm g{wsp<const bf16>(F, WS_HME), wsp<const bf16>(F, WS_EW2), DFE, DFE, DFE}; pg8::Order S; S.init(cnp, 4, F.G, bx, pg8::OM_MOE, cnp, (size_t)256 * DFE, (size_t)256 * DFE, 0, (size_t)1024 * DFE); \
        S.pexp = F.ctl + CW_PEXP; S.pbase = cbase; S.apan0 = cbase; \
        EpiMoe2<(half) != 0> E{(half) ? F.X3P : F.XL, (half) ? (void*)F.OUT : (void*)F.X3P, wsp<const int>(F, WS_STOK), wsp<const float>(F, WS_SW), MOD1}; pg8::gemm_phase<EpiMoe2<(half) != 0>, pg8::Order, true, true>(ring, g, S, E); }
    MOE_DOWN(0, 20) SEAM(20);
    MOE_DOWN(1, 21)
#undef MOE_DOWN
#undef IN
#undef SEAM
}

extern "C" void kernel_launch(void* const* d_in, const int* in_sizes, int n_in, void* d_out, int out_size, void* d_ws, size_t ws_size, hipStream_t stream) {
    static int grid = 0;
    if (grid == 0) {
        if (n_in != 39 || out_size != MLAT * D || ws_size < WS_END) { fprintf(stderr, "kernel_launch: unexpected shapes (n_in %d, out %d, ws %zu)\n", n_in, out_size, ws_size); grid = -1; return; }
        int dev = 0, cus = 0, per_cu = 0;
        if (hipGetDevice(&dev) != hipSuccess || hipDeviceGetAttribute(&cus, hipDeviceAttributeMultiprocessorCount, dev) != hipSuccess) { grid = -1; return; }
        if (hipFuncSetAttribute((const void*)mk_fwd, hipFuncAttributeMaxDynamicSharedMemorySize, LDS_BYTES) != hipSuccess) { fprintf(stderr, "kernel_launch: hipFuncSetAttribute failed\n"); grid = -1; return; }
        if (hipOccupancyMaxActiveBlocksPerMultiprocessor(&per_cu, (const void*)mk_fwd, NWAVES * 64, LDS_BYTES) != hipSuccess || per_cu < 1)
            fprintf(stderr, "kernel_launch: note: occupancy query reports %d workgroups per CU\n", per_cu);
        (void)hipGetLastError();
        grid = cus;
    }
    if (grid < 0) return;
    if (hipMemsetAsync((char*)d_ws + WS_CTL, 0, CTL_ZERO_BYTES, stream) != hipSuccess) return;
    Args a{};
    for (int i = 0; i < 39; ++i) a.in[i] = (const float*)d_in[i];
    a.out = (float*)d_out; a.ws = (unsigned char*)d_ws; a.pad = 0;
#if MK_PER_PHASE
    for (int li = 0; li < NPH; ++li) { a.ph_lo = li; a.ph_hi = li + 1; a.li = li; hipLaunchKernelGGL(mk_fwd, dim3(grid), dim3(NWAVES * 64), LDS_BYTES, stream, a); }
#else
    a.ph_lo = 0; a.ph_hi = NPH; a.li = 0;
    hipLaunchKernelGGL(mk_fwd, dim3(grid), dim3(NWAVES * 64), LDS_BYTES, stream, a);
#endif
}
```
